# Optimizing an MI355X kernel written in HIP

```python
import math
import jax
import jax.numpy as jnp
from jax import lax
import numpy as np

D_MODEL = 1024
BATCH = 4
SEQ = 8192
DEPTH = 1

CHUNK = 64
Q_BLOCK = 128
PLE_DIM = 256
EPS = 1e-6
NEG_INF = -1e30

MLA_HEADS = 8
MLA_Q_RANK = 256
MLA_KV_RANK = 128
MLA_NOPE = 64
MLA_ROPE = 32
MLA_QK = MLA_NOPE + MLA_ROPE
MLA_V = 64
ROPE_THETA = 10000.0

DIFF_HEADS = 4
DIFF_QK = 64
DIFF_V = 2 * DIFF_QK

MIX_WIDTH = MLA_HEADS * MLA_V + DIFF_HEADS * DIFF_V

NUM_BUCKETS = 32
MAX_DISTANCE = 1024

D_FF = 2816
CONV_WIDTH = 3

OFF_Q_LAT = 0
OFF_KV_LAT = OFF_Q_LAT + MLA_Q_RANK
OFF_K_ROPE = OFF_KV_LAT + MLA_KV_RANK
OFF_DIFF_Q = OFF_K_ROPE + MLA_ROPE
OFF_DIFF_K = OFF_DIFF_Q + DIFF_HEADS * 2 * DIFF_QK
OFF_DIFF_V = OFF_DIFF_K + DIFF_HEADS * 2 * DIFF_QK
IN_COLS = OFF_DIFF_V + DIFF_HEADS * DIFF_V

kernel_name = 'hybrid_mla_diffattn_convffn_ple'


def lambda_init(layer):
    return 0.8 - 0.6 * math.exp(-0.3 * layer)


def rms_norm(x, g):
    xf = x.astype(jnp.float32)
    y = xf * lax.rsqrt(jnp.mean(xf * xf, axis=-1, keepdims=True) + EPS)
    return (y * g.astype(jnp.float32)).astype(x.dtype)


def apply_rope(t, pos):
    half = t.shape[-1] // 2
    inv_freq = ROPE_THETA ** (-jnp.arange(half, dtype=jnp.float32) / half)
    ang = pos.astype(jnp.float32)[:, None] * inv_freq[None, :]
    cos = jnp.cos(ang)[None, :, None, :].astype(t.dtype)
    sin = jnp.sin(ang)[None, :, None, :].astype(t.dtype)
    t1, t2 = t[..., :half], t[..., half:]
    return jnp.concatenate([t1 * cos - t2 * sin, t2 * cos + t1 * sin], axis=-1)


def t5_bucket(rel):
    nb = NUM_BUCKETS // 2
    max_exact = nb // 2
    sign_off = (rel > 0).astype(jnp.int32) * nb
    n = jnp.abs(rel)
    nf = jnp.maximum(n, 1).astype(jnp.float32)
    large = max_exact + (jnp.log(nf / max_exact) / math.log(MAX_DISTANCE / max_exact)
                         * (nb - max_exact)).astype(jnp.int32)
    large = jnp.minimum(large, nb - 1)
    return sign_off + jnp.where(n < max_exact, n, large)


def block_indices(blk, seq):
    q_idx = blk * Q_BLOCK + jnp.arange(Q_BLOCK, dtype=jnp.int32)
    k_idx = jnp.arange(seq, dtype=jnp.int32)
    return q_idx, k_idx


def chunk_allowed(q_idx, k_idx):
    return (k_idx[None, :] // CHUNK) <= (q_idx[:, None] // CHUNK)


def to_blocks(t):
    b, s, h, d = t.shape
    return t.reshape(b, s // Q_BLOCK, Q_BLOCK, h, d).transpose(1, 0, 3, 2, 4)


def from_blocks(t):
    n, b, h, qb, d = t.shape
    return t.transpose(1, 0, 3, 2, 4).reshape(b, n * qb, h, d)


def mla_group(q_lat, kv_lat, k_rope, pos, q_lat_g, w_uq, kv_lat_g, w_ukv, q_g, k_g):
    b, s, _ = q_lat.shape
    q = (rms_norm(q_lat, q_lat_g) @ w_uq).reshape(b, s, MLA_HEADS, MLA_QK)
    kv = (rms_norm(kv_lat, kv_lat_g) @ w_ukv).reshape(b, s, MLA_HEADS, MLA_NOPE + MLA_V)
    k_nope, v = kv[..., :MLA_NOPE], kv[..., MLA_NOPE:]
    k_r = jnp.broadcast_to(k_rope[:, :, None, :], (b, s, MLA_HEADS, MLA_ROPE))
    k = jnp.concatenate([k_nope, k_r], axis=-1)
    q = rms_norm(q, q_g)
    k = rms_norm(k, k_g)
    q = jnp.concatenate([q[..., :MLA_NOPE], apply_rope(q[..., MLA_NOPE:], pos)], axis=-1)
    k = jnp.concatenate([k[..., :MLA_NOPE], apply_rope(k[..., MLA_NOPE:], pos)], axis=-1)
    k_t = k.transpose(0, 2, 1, 3)
    v_t = v.transpose(0, 2, 1, 3)
    scale = MLA_QK ** -0.5

    def one_block(args):
        qb, blk = args
        q_idx, k_idx = block_indices(blk, s)
        allowed = chunk_allowed(q_idx, k_idx)
        logits = jnp.einsum('bhqd,bhkd->bhqk', qb, k_t).astype(jnp.float32) * scale
        logits = jnp.where(allowed[None, None], logits, NEG_INF)
        probs = jax.nn.softmax(logits, axis=-1).astype(v_t.dtype)
        return jnp.einsum('bhqk,bhkd->bhqd', probs, v_t)

    o = lax.map(one_block, (to_blocks(q), jnp.arange(s // Q_BLOCK, dtype=jnp.int32)))
    return from_blocks(o).reshape(b, s, MLA_HEADS * MLA_V)


def diff_group(dq, dk, dv, q_g, k_g, lq1, lk1, lq2, lk2, out_g, rel_bias, lam_init):
    b, s, _ = dq.shape
    q = rms_norm(dq.reshape(b, s, DIFF_HEADS, 2, DIFF_QK), q_g)
    k = rms_norm(dk.reshape(b, s, DIFF_HEADS, 2, DIFF_QK), k_g)
    k_t = k.transpose(0, 2, 3, 1, 4)
    v_t = dv.reshape(b, s, DIFF_HEADS, DIFF_V).transpose(0, 2, 1, 3)
    f32 = jnp.float32
    lam = (jnp.exp(jnp.sum(lq1.astype(f32) * lk1.astype(f32)))
           - jnp.exp(jnp.sum(lq2.astype(f32) * lk2.astype(f32))) + lam_init)
    scale = DIFF_QK ** -0.5
    table = rel_bias.astype(f32)

    def one_block(args):
        qb, blk = args
        qb = qb.reshape(b, DIFF_HEADS, Q_BLOCK, 2, DIFF_QK)
        q_idx, k_idx = block_indices(blk, s)
        allowed = chunk_allowed(q_idx, k_idx)
        bias = table[t5_bucket(k_idx[None, :] - q_idx[:, None])].transpose(2, 0, 1)
        logits = jnp.einsum('bhqmd,bhmkd->bhmqk', qb, k_t).astype(f32) * scale
        logits = logits + bias[None, :, None]
        logits = jnp.where(allowed[None, None, None], logits, NEG_INF)
        probs = jax.nn.softmax(logits, axis=-1)
        attn = (probs[:, :, 0] - lam * probs[:, :, 1]).astype(v_t.dtype)
        return jnp.einsum('bhqk,bhkd->bhqd', attn, v_t)

    qf = q.reshape(b, s, DIFF_HEADS, 2 * DIFF_QK)
    o = lax.map(one_block, (to_blocks(qf), jnp.arange(s // Q_BLOCK, dtype=jnp.int32)))
    o = rms_norm(from_blocks(o), out_g) * (1.0 - lam_init)
    return o.reshape(b, s, DIFF_HEADS * DIFF_V)


def conv_ffn(h, w_gate, w_up, conv_w, conv_b, w_down):
    s = h.shape[1]
    g = h @ w_gate
    gp = jnp.pad(g, ((0, 0), (CONV_WIDTH - 1, 0), (0, 0)))
    conv = conv_b
    for j in range(CONV_WIDTH):
        conv = conv + gp[:, j:j + s, :] * conv_w[j]
    return (jax.nn.silu(conv) * (h @ w_up)) @ w_down


def setup_inputs(seed: int = 0) -> dict:
    key = jax.random.key(seed)
    ks = jax.random.split(key, 28)
    f32 = jnp.float32

    def nrm(k, shape, scale):
        return jax.random.normal(k, shape, dtype=f32) * scale

    def gain(k, shape):
        return 1.0 + 0.1 * jax.random.normal(k, shape, dtype=f32)

    return {
        'x': nrm(ks[0], (BATCH, SEQ, D_MODEL), 1.0),
        'p': nrm(ks[1], (DEPTH, BATCH, SEQ, PLE_DIM), 1.0),
        'attn_norm_g': gain(ks[2], (DEPTH, D_MODEL)),
        'w_in': nrm(ks[3], (DEPTH, D_MODEL, IN_COLS), D_MODEL ** -0.5),
        'q_lat_norm_g': gain(ks[4], (DEPTH, MLA_Q_RANK)),
        'w_uq': nrm(ks[5], (DEPTH, MLA_Q_RANK, MLA_HEADS * MLA_QK), MLA_Q_RANK ** -0.5),
        'kv_lat_norm_g': gain(ks[6], (DEPTH, MLA_KV_RANK)),
        'w_ukv': nrm(ks[7], (DEPTH, MLA_KV_RANK, MLA_HEADS * (MLA_NOPE + MLA_V)), MLA_KV_RANK ** -0.5),
        'mla_q_norm_g': gain(ks[8], (DEPTH, MLA_QK)),
        'mla_k_norm_g': gain(ks[9], (DEPTH, MLA_QK)),
        'diff_q_norm_g': gain(ks[10], (DEPTH, DIFF_QK)),
        'diff_k_norm_g': gain(ks[11], (DEPTH, DIFF_QK)),
        'lambda_q1': nrm(ks[12], (DEPTH, DIFF_QK), 0.1),
        'lambda_k1': nrm(ks[13], (DEPTH, DIFF_QK), 0.1),
        'lambda_q2': nrm(ks[14], (DEPTH, DIFF_QK), 0.1),
        'lambda_k2': nrm(ks[15], (DEPTH, DIFF_QK), 0.1),
        'diff_out_norm_g': gain(ks[16], (DEPTH, DIFF_V)),
        'rel_bias': nrm(ks[17], (NUM_BUCKETS, DIFF_HEADS), 0.5),
        'w_out': nrm(ks[18], (DEPTH, MIX_WIDTH, D_MODEL), MIX_WIDTH ** -0.5),
        'ffn_norm_g': gain(ks[19], (DEPTH, D_MODEL)),
        'w_gate': nrm(ks[20], (DEPTH, D_MODEL, D_FF), D_MODEL ** -0.5),
        'w_up': nrm(ks[21], (DEPTH, D_MODEL, D_FF), D_MODEL ** -0.5),
        'conv_w': nrm(ks[22], (DEPTH, CONV_WIDTH, D_FF), CONV_WIDTH ** -0.5),
        'conv_b': nrm(ks[23], (DEPTH, D_FF), 0.02),
        'w_down': nrm(ks[24], (DEPTH, D_FF, D_MODEL), D_FF ** -0.5),
        'ple_norm_g': gain(ks[25], (DEPTH, D_MODEL)),
        'w_ple_gate': nrm(ks[26], (DEPTH, D_MODEL, D_MODEL), D_MODEL ** -0.5),
        'w_ple_proj': nrm(ks[27], (DEPTH, PLE_DIM, D_MODEL), PLE_DIM ** -0.5),
    }


def reference(x, p, attn_norm_g, w_in, q_lat_norm_g, w_uq, kv_lat_norm_g, w_ukv,
              mla_q_norm_g, mla_k_norm_g, diff_q_norm_g, diff_k_norm_g,
              lambda_q1, lambda_k1, lambda_q2, lambda_k2, diff_out_norm_g, rel_bias,
              w_out, ffn_norm_g, w_gate, w_up, conv_w, conv_b, w_down,
              ple_norm_g, w_ple_gate, w_ple_proj):
    s = x.shape[1]
    pos = jnp.arange(s, dtype=jnp.int32)
    for i in range(DEPTH):
        h = rms_norm(x, attn_norm_g[i])
        z = h @ w_in[i]
        y_mla = mla_group(z[..., OFF_Q_LAT:OFF_KV_LAT], z[..., OFF_KV_LAT:OFF_K_ROPE],
                          z[..., OFF_K_ROPE:OFF_DIFF_Q], pos,
                          q_lat_norm_g[i], w_uq[i], kv_lat_norm_g[i], w_ukv[i],
                          mla_q_norm_g[i], mla_k_norm_g[i])
        y_diff = diff_group(z[..., OFF_DIFF_Q:OFF_DIFF_K], z[..., OFF_DIFF_K:OFF_DIFF_V],
                            z[..., OFF_DIFF_V:IN_COLS],
                            diff_q_norm_g[i], diff_k_norm_g[i],
                            lambda_q1[i], lambda_k1[i], lambda_q2[i], lambda_k2[i],
                            diff_out_norm_g[i], rel_bias, lambda_init(i))
        x = x + jnp.concatenate([y_mla, y_diff], axis=-1) @ w_out[i]
        x = x + conv_ffn(rms_norm(x, ffn_norm_g[i]), w_gate[i], w_up[i], conv_w[i], conv_b[i], w_down[i])
        gate = jax.nn.sigmoid(rms_norm(x, ple_norm_g[i]) @ w_ple_gate[i])
        x = x + gate * (p[i] @ w_ple_proj[i])
    return x
```

```cpp
#include <hip/hip_runtime.h>
#include <cstdio>
#include <cstdint>
#include <cmath>

#define LAS __attribute__((address_space(3)))
#define GAS __attribute__((address_space(1)))
typedef unsigned short bf16_t;
typedef short bf16x8 __attribute__((ext_vector_type(8)));
typedef short s16x4 __attribute__((ext_vector_type(4)));
typedef short s16x8 __attribute__((ext_vector_type(8)));
typedef float f32x2 __attribute__((ext_vector_type(2)));
typedef float f32x4 __attribute__((ext_vector_type(4)));
typedef float f32x16 __attribute__((ext_vector_type(16)));
typedef unsigned u32x2 __attribute__((ext_vector_type(2)));
typedef unsigned u32x4 __attribute__((ext_vector_type(4)));
typedef __bf16 bf16x2_t __attribute__((ext_vector_type(2)));

constexpr int D_MODEL = 1024, BATCH = 4, SEQ = 8192, PLE_DIM = 256, T_TOK = BATCH * SEQ;
constexpr int D_FF = 2816;
constexpr int OFF_Q_LAT = 0, OFF_KV_LAT = 256, OFF_K_ROPE = 384, OFF_DIFF_Q = 416, OFF_DIFF_K = 928, OFF_DIFF_V = 1440, IN_COLS = 1952;
constexpr float EPS = 1e-6f;
constexpr float LOG2E = 1.4426950408889634f;
constexpr int ZLD = 1024;
constexpr int Z_DQ = 512;
__host__ __device__ __forceinline__ size_t kimg(int nch, int bh, int t, int c, int r) { return ((((size_t)bh * (SEQ / 64) + t) * nch + c) * 64 + r) * 8; }
__host__ __device__ __forceinline__ size_t vimg(int nd, int bh, int t, int d0, int ks, int r16, int col) { return ((((size_t)bh * (SEQ / 64) + t) * nd + d0) * 4 + ks) * 512 + r16 * 32 + col; }

__device__ __forceinline__ unsigned cvtpk(float lo, float hi) { f32x2 v = {lo, hi}; bf16x2_t b = __builtin_convertvector(v, bf16x2_t); return __builtin_bit_cast(unsigned, b); }
__device__ __forceinline__ float bf2f(short h) { return __uint_as_float(((unsigned)(unsigned short)h) << 16); }
__device__ __forceinline__ float bflo(unsigned w) { return __uint_as_float(w << 16); }
__device__ __forceinline__ float bfhi(unsigned w) { return __uint_as_float(w & 0xffff0000u); }

namespace pg8 {
constexpr int BM = 256, BK = 64, HALF = 128, HTB = HALF * BK * 2, STAGE_BYTES = 8 * HTB, NXCD = 8, WGM = 8;
__host__ __device__ __forceinline__ int lds_byte(int r, int c) { const int st = (r >> 4) * 2 + (c >> 5), rr = r & 15, cc = c & 31, ob = rr * 64 + cc * 2; return st * 1024 + (ob ^ (((ob >> 9) & 1) << 5)); }
__host__ __device__ __forceinline__ void stage_rc(int b, int& R, int& C) { const int st = b / 1024, sb = b % 1024, swz = sb ^ (((sb >> 9) & 1) << 5); R = (st >> 1) * 16 + swz / 64; C = (st & 1) * 32 + (swz % 64) / 2; }
__host__ __device__ __forceinline__ int perm32(int rho) { const int n = rho >> 4, i = rho & 15; return 8 * (i >> 2) + 4 * n + (i & 3); }

struct Unit { int pm, pn; };
struct Gemm { const bf16_t* A; const bf16_t* Bt; int M, N, K, lda; };

struct StaticOrder {
    int nM, nN, nwg, G, c;
    __host__ __device__ void init(int M, int N, int G_, int c_) { nM = M / BM; nN = N / BM; nwg = nM * nN; G = G_; c = c_; }
    __host__ __device__ bool next(int i, Unit& u) const {
        const long L = (long)i * G + c; if (L >= nwg) return false;
        int wgid = (int)L; { const int q = nwg / NXCD, r = nwg % NXCD, xcd = wgid % NXCD, off = wgid / NXCD; wgid = (xcd < r ? xcd * (q + 1) : r * (q + 1) + (xcd - r) * q) + off; }
        const int nig = WGM * nN, gid = wgid / nig, fm = gid * WGM, gsz = (nM - fm) < WGM ? (nM - fm) : WGM;
        u.pm = fm + ((wgid % nig) % gsz); u.pn = (wgid % nig) / gsz; return true;
    }
};

template <class Epi, class Sched>
__device__ __forceinline__ void gemm_phase(LAS unsigned char* lds, const Gemm g, const Sched& S, const Epi& E) {
    const int tid = threadIdx.x, wid = __builtin_amdgcn_readfirstlane(tid >> 6), lane = tid & 63, wr = wid >> 2, wc = wid & 3, fr = lane & 15, fq = lane >> 4;
    const int K = g.K, nt = K / BK, lda = g.lda;
    unsigned voffA[2], voffB[2];
#pragma unroll
    for (int i = 0; i < 2; ++i) { int R, C; stage_rc(tid * 16 + i * 8192, R, C); const int Rb = (R & ~31) + perm32(R & 31);
        voffA[i] = (unsigned)(R * lda + C) * 2u; voffB[i] = (unsigned)(Rb * K + C) * 2u; }
    const size_t kstep = (size_t)(BK * 2);
    const size_t hstepA = (size_t)HALF * lda * 2, hstepB = (size_t)HALF * K * 2;
    const size_t tstepA = 2 * hstepA, tstepB = 2 * hstepB;
    const unsigned ldsw = (unsigned)wid * 1024u;
    const int aoff = lds_byte(wr * 64 + fr, fq * 8), boff = lds_byte(wc * 32 + fr, fq * 8);
#define PG8_SA(b, h) (((b) * 2 + (h)) * HTB)
#define PG8_SB(b, h) ((4 + (b) * 2 + (h)) * HTB)
#define PG8_STAGE(bufoff, gbase, voff) do { _Pragma("unroll") for (int _i = 0; _i < 2; ++_i) \
        __builtin_amdgcn_global_load_lds((const unsigned*)((const char*)(gbase) + (voff)[_i]), (LAS unsigned*)(lds + (bufoff) + ldsw + _i * 8192), 16, 0, 0); } while (0)
#define PG8_LDA(dst, b, h) do { _Pragma("unroll") for (int m = 0; m < 4; ++m) _Pragma("unroll") for (int k = 0; k < 2; ++k) dst[m][k] = *(const LAS bf16x8*)(lds + PG8_SA(b, h) + aoff + m * 2048 + k * 1024); } while (0)
#define PG8_LDB(dst, b, h) do { _Pragma("unroll") for (int n = 0; n < 2; ++n) _Pragma("unroll") for (int k = 0; k < 2; ++k) dst[n][k] = *(const LAS bf16x8*)(lds + PG8_SB(b, h) + boff + n * 2048 + k * 1024); } while (0)
#define PG8_MMA(ai, bj, At, Bt) do { __builtin_amdgcn_s_setprio(1); _Pragma("unroll") for (int m = 0; m < 4; ++m) _Pragma("unroll") for (int n = 0; n < 2; ++n) _Pragma("unroll") for (int k = 0; k < 2; ++k) \
        acc[ai][bj][m][n] = __builtin_amdgcn_mfma_f32_16x16x32_bf16(Bt[n][k], At[m][k], acc[ai][bj][m][n], 0, 0, 0); __builtin_amdgcn_s_setprio(0); } while (0)
#define PG8_WAIT_V(n) asm volatile("s_waitcnt vmcnt(" #n ")" ::: "memory")
#define PG8_WAIT_L(n) asm volatile("s_waitcnt lgkmcnt(" #n ")" ::: "memory")
#define PG8_BAR __builtin_amdgcn_s_barrier()
#define PG8_SCHED __builtin_amdgcn_sched_barrier(0)
    Unit cur, nxt; int ui = 0;
    if (!S.next(0, cur)) return;
    f32x4 acc[2][2][4][2];
#pragma unroll
    for (int a = 0; a < 2; ++a)
#pragma unroll
        for (int b = 0; b < 2; ++b)
#pragma unroll
            for (int m = 0; m < 4; ++m)
#pragma unroll
                for (int n = 0; n < 2; ++n) acc[a][b][m][n] = (f32x4){0.f, 0.f, 0.f, 0.f};
    bf16x8 At[4][2], B0[2][2], B1[2][2];
    const char* cA = (const char*)g.A + (size_t)cur.pm * tstepA; const char* cB = (const char*)g.Bt + (size_t)cur.pn * tstepB;
    PG8_STAGE(PG8_SB(0, 0), cB, voffB); PG8_STAGE(PG8_SB(0, 1), cB + hstepB, voffB); PG8_STAGE(PG8_SA(0, 0), cA, voffA); PG8_STAGE(PG8_SA(0, 1), cA + hstepA, voffA);
    if (wr == 1) PG8_BAR;
    PG8_WAIT_V(2); PG8_BAR;
    PG8_STAGE(PG8_SB(1, 0), cB + kstep, voffB); PG8_STAGE(PG8_SA(1, 0), cA + kstep, voffA); PG8_STAGE(PG8_SB(1, 1), cB + hstepB + kstep, voffB);
    PG8_WAIT_V(6); PG8_BAR;
    for (;;) {
        const bool has_next = S.next(ui + 1, nxt);
        const char* nA = has_next ? (const char*)g.A + (size_t)nxt.pm * tstepA : cA; const char* nB = has_next ? (const char*)g.Bt + (size_t)nxt.pn * tstepB : cB;
#pragma unroll 1
        for (int t = 0; t < nt; t += 2) {
            const bool last = (t == nt - 2);
            const char* a1 = cA + (size_t)(t + 1) * kstep;
            const char* a2 = last ? nA : cA + (size_t)(t + 2) * kstep; const char* b2 = last ? nB : cB + (size_t)(t + 2) * kstep;
            const char* a3 = a2 + kstep; const char* b3 = b2 + kstep;
            PG8_LDB(B0, 0, 0); PG8_LDB(B1, 0, 1); PG8_SCHED; PG8_LDA(At, 0, 0); PG8_STAGE(PG8_SA(1, 1), a1 + hstepA, voffA);
            PG8_WAIT_V(8); PG8_WAIT_L(0); PG8_BAR; PG8_MMA(0, 0, At, B0); PG8_MMA(0, 1, At, B1); PG8_BAR; PG8_SCHED;
            PG8_LDA(At, 0, 1); PG8_STAGE(PG8_SB(0, 0), b2, voffB); PG8_STAGE(PG8_SB(0, 1), b2 + hstepB, voffB); PG8_STAGE(PG8_SA(0, 0), a2, voffA);
            PG8_WAIT_V(8); PG8_WAIT_L(0); PG8_BAR; PG8_MMA(1, 0, At, B0); PG8_MMA(1, 1, At, B1); PG8_BAR; PG8_SCHED;
            PG8_LDB(B0, 1, 0); PG8_LDB(B1, 1, 1); PG8_SCHED; PG8_LDA(At, 1, 0); PG8_STAGE(PG8_SA(0, 1), a2 + hstepA, voffA);
            PG8_WAIT_V(8); PG8_WAIT_L(0); PG8_BAR; PG8_MMA(0, 0, At, B0); PG8_MMA(0, 1, At, B1); PG8_BAR; PG8_SCHED;
            PG8_LDA(At, 1, 1); PG8_STAGE(PG8_SB(1, 0), b3, voffB); PG8_STAGE(PG8_SB(1, 1), b3 + hstepB, voffB); PG8_STAGE(PG8_SA(1, 0), a3, voffA);
            PG8_WAIT_V(8); PG8_WAIT_L(0); PG8_BAR; PG8_MMA(1, 0, At, B0); PG8_MMA(1, 1, At, B1); PG8_BAR; PG8_SCHED;
        }
        if (wr == 0) PG8_BAR;
        E(acc, cur, wr, wc, fr, fq);
        if (!has_next) break;
#pragma unroll
        for (int a = 0; a < 2; ++a)
#pragma unroll
            for (int b = 0; b < 2; ++b)
#pragma unroll
                for (int m = 0; m < 4; ++m)
#pragma unroll
                    for (int n = 0; n < 2; ++n) acc[a][b][m][n] = (f32x4){0.f, 0.f, 0.f, 0.f};
        cur = nxt; cA = nA; cB = nB; ++ui;
        if (wr == 1) PG8_BAR;
    }
    PG8_WAIT_V(0);
    PG8_BAR;
#undef PG8_SA
#undef PG8_SB
#undef PG8_STAGE
#undef PG8_LDA
#undef PG8_LDB
#undef PG8_MMA
#undef PG8_WAIT_V
#undef PG8_WAIT_L
#undef PG8_BAR
#undef PG8_SCHED
}
}

constexpr int NWAVES_C = 8;
typedef f32x4 AccT[2][2][4][2];
__device__ __forceinline__ u32x4 pack8(const f32x4 a, const f32x4 b) { u32x4 w; w.x = cvtpk(a[0], a[1]); w.y = cvtpk(a[2], a[3]); w.z = cvtpk(b[0], b[1]); w.w = cvtpk(b[2], b[3]); return w; }
__device__ __forceinline__ float sq4(const f32x4 a) { return (a[0] * a[0] + a[1] * a[1]) + (a[2] * a[2] + a[3] * a[3]); }
__device__ __forceinline__ float red_fq(float s) { s += __shfl_xor(s, 16); s += __shfl_xor(s, 32); return s; }

__device__ __forceinline__ void v_piece_store(LAS unsigned char* scr, int fr, int fq, const u32x4 w, bf16_t* piece) {
    *(LAS u32x4*)(scr + fr * 64 + fq * 16) = w;
    asm volatile("" ::: "memory");
    LAS unsigned char* tp = scr + (fq & 1) * 32 + (fr & 3) * 8 + (4 * (fq >> 1) + (fr >> 2)) * 64;
    const s16x4 lo = __builtin_bit_cast(s16x4, __builtin_amdgcn_ds_read_tr16_b64_v4i16((LAS s16x4*)tp)), hh = __builtin_bit_cast(s16x4, __builtin_amdgcn_ds_read_tr16_b64_v4i16((LAS s16x4*)(tp + 512)));
    asm volatile("" ::: "memory");
    *(s16x8*)(piece + (fq * 16 + fr) * 8) = (s16x8){lo[0], lo[1], lo[2], lo[3], hh[0], hh[1], hh[2], hh[3]};
}

struct EpiIn {
    LAS unsigned char* vscr; bf16_t* Z; bf16_t* DKI; bf16_t* DVI; float* SSQ; float* SSKV; float* KRR; float* KRSS; const float* rope; const float* gdq; const float* gdk; const float* gmk;
    __device__ __forceinline__ void operator()(const AccT& acc, const pg8::Unit& u, int wr, int wc, int fr, int fq) const {
        const int pn = u.pn, row0 = u.pm * 256 + wr * 64 + fr;
        if (pn >= 6) {
#pragma unroll
            for (int ai = 0; ai < 2; ++ai)
#pragma unroll
                for (int m = 0; m < 4; ++m) { const int row = row0 + ai * 128 + m * 16, b = row >> 13, sq = row & (SEQ - 1);
#pragma unroll
                    for (int bj = 0; bj < 2; ++bj)
                        v_piece_store(vscr + (wr * 4 + wc) * 1024, fr, fq, pack8(acc[ai][bj][m][0], acc[ai][bj][m][1]), DVI + vimg(4, b * 4 + 2 * (pn - 6) + bj, sq >> 6, wc, m, 0, 0)); }
        } else if (pn == 0) {
#pragma unroll
            for (int ai = 0; ai < 2; ++ai)
#pragma unroll
                for (int m = 0; m < 4; ++m) { const int row = row0 + ai * 128 + m * 16; bf16_t* rp = Z + (size_t)row * ZLD + pn * 256 + wc * 32 + 8 * fq; float s = 0.f;
#pragma unroll
                    for (int bj = 0; bj < 2; ++bj) { *(u32x4*)(rp + bj * 128) = pack8(acc[ai][bj][m][0], acc[ai][bj][m][1]); s += sq4(acc[ai][bj][m][0]) + sq4(acc[ai][bj][m][1]); }
                    if (pn == 0) { s = red_fq(s); if (fq == 0) SSQ[(size_t)row * 4 + wc] = s; } }
        } else if (pn == 1) {
#pragma unroll
            for (int ai = 0; ai < 2; ++ai)
#pragma unroll
                for (int m = 0; m < 4; ++m) { const int row = row0 + ai * 128 + m * 16;
                    *(u32x4*)(Z + (size_t)row * ZLD + 256 + wc * 32 + 8 * fq) = pack8(acc[ai][0][m][0], acc[ai][0][m][1]);
                    float s = red_fq(sq4(acc[ai][0][m][0]) + sq4(acc[ai][0][m][1])); if (fq == 0) SSKV[(size_t)row * 4 + wc] = s;
                    if (wc == 0) {
                        const f32x4 v0 = acc[ai][1][m][0], v1 = acc[ai][1][m][1];
                        float ss = red_fq(sq4(v0) + sq4(v1)); if (fq == 0) KRSS[row] = ss;
                        const f32x4 g0 = *(const f32x4*)(gmk + 64 + 8 * fq), g1 = *(const f32x4*)(gmk + 64 + 8 * fq + 4);
                        const f32x4 a0 = v0 * g0, a1 = v1 * g1;
                        f32x4 b0, b1;
#pragma unroll
                        for (int e = 0; e < 4; ++e) { b0[e] = __shfl_xor(a0[e], 32); b1[e] = __shfl_xor(a1[e], 32); }
                        const int pos = row & (SEQ - 1); const float* rp = rope + (size_t)pos * 32 + 8 * (fq & 1);
                        const f32x4 c0 = *(const f32x4*)(rp), c1 = *(const f32x4*)(rp + 4), s0 = *(const f32x4*)(rp + 16), s1 = *(const f32x4*)(rp + 20);
                        f32x4 o0, o1;
                        if (fq < 2) { o0 = a0 * c0 - b0 * s0; o1 = a1 * c1 - b1 * s1; } else { o0 = a0 * c0 + b0 * s0; o1 = a1 * c1 + b1 * s1; }
                        *(f32x4*)(KRR + (size_t)row * 32 + 8 * fq) = o0; *(f32x4*)(KRR + (size_t)row * 32 + 8 * fq + 4) = o1;
                    } }
        } else {
            const bool isq = pn < 4; const float* g = isq ? gdq : gdk; const float sc = isq ? 0.125f * LOG2E : 1.0f;
            const int G = 4 * ((pn - 2) & 1) + wc; const int colb = Z_DQ + 64 * G + 8 * fq;
            f32x4 gg[2][2];
#pragma unroll
            for (int bj = 0; bj < 2; ++bj) { gg[bj][0] = *(const f32x4*)(g + 32 * bj + 8 * fq) * sc; gg[bj][1] = *(const f32x4*)(g + 32 * bj + 8 * fq + 4) * sc; }
#pragma unroll
            for (int ai = 0; ai < 2; ++ai)
#pragma unroll
                for (int m = 0; m < 4; ++m) { const int row = row0 + ai * 128 + m * 16;
                    float s = (sq4(acc[ai][0][m][0]) + sq4(acc[ai][0][m][1])) + (sq4(acc[ai][1][m][0]) + sq4(acc[ai][1][m][1])); s = red_fq(s);
                    const float r = rsqrtf(s * (1.0f / 64.0f) + EPS);
#pragma unroll
                    for (int bj = 0; bj < 2; ++bj) { const u32x4 w = pack8(acc[ai][bj][m][0] * gg[bj][0] * r, acc[ai][bj][m][1] * gg[bj][1] * r);
                        if (isq) *(u32x4*)(Z + (size_t)row * ZLD + colb + 32 * bj) = w;
                        else *(u32x4*)(DKI + kimg(8, (row >> 13) * 8 + G, (row & (SEQ - 1)) >> 6, 4 * bj + fq, row & 63)) = w; } }
        }
    }
};

template <bool KV> struct EpiUp {
    LAS unsigned char* vscr; bf16_t* QR; bf16_t* KM; bf16_t* VM; const float* SSQ; const float* SSKV; const float* KRR; const float* KRSS; const float* gmk;
    __device__ __forceinline__ void operator()(const AccT& acc, const pg8::Unit& u, int wr, int wc, int fr, int fq) const {
        const int pn = u.pn, row0 = u.pm * 256 + wr * 64 + fr;
        if (!KV || pn >= 2) {
            const float* SSp = KV ? SSKV : SSQ; const float inv = KV ? (1.0f / 128.0f) : (1.0f / 256.0f);
#pragma unroll
            for (int ai = 0; ai < 2; ++ai)
#pragma unroll
                for (int m = 0; m < 4; ++m) { const int row = row0 + ai * 128 + m * 16;
                    const f32x4 s4 = *(const f32x4*)(SSp + (size_t)row * 4); const float r = rsqrtf(((s4[0] + s4[1]) + (s4[2] + s4[3])) * inv + EPS);
#pragma unroll
                    for (int bj = 0; bj < 2; ++bj) { const u32x4 w = pack8(acc[ai][bj][m][0] * r, acc[ai][bj][m][1] * r);
                        if (!KV) *(u32x4*)(QR + (size_t)row * 768 + pn * 256 + bj * 128 + wc * 32 + 8 * fq) = w;
                        else { const int sq = row & (SEQ - 1);
                            v_piece_store(vscr + (wr * 4 + wc) * 1024, fr, fq, w, VM + vimg(2, (row >> 13) * 8 + 4 * (pn - 2) + 2 * bj + (wc >> 1), sq >> 6, wc & 1, m, 0, 0)); } }
                    if (m & 1) asm volatile("" ::: "memory"); }
        } else {
            const int hh = 4 * pn + wc;
            f32x4 gg[2][2];
#pragma unroll
            for (int bj = 0; bj < 2; ++bj) { gg[bj][0] = *(const f32x4*)(gmk + 32 * bj + 8 * fq); gg[bj][1] = *(const f32x4*)(gmk + 32 * bj + 8 * fq + 4); }
#pragma unroll
            for (int ai = 0; ai < 2; ++ai)
#pragma unroll
                for (int m = 0; m < 4; ++m) { const int row = row0 + ai * 128 + m * 16;
                    const f32x4 s4 = *(const f32x4*)(SSKV + (size_t)row * 4); const float r = rsqrtf(((s4[0] + s4[1]) + (s4[2] + s4[3])) * (1.0f / 128.0f) + EPS);
                    float s = (sq4(acc[ai][0][m][0]) + sq4(acc[ai][0][m][1])) + (sq4(acc[ai][1][m][0]) + sq4(acc[ai][1][m][1]));
                    s = red_fq(s) * (r * r);
                    const float rk = rsqrtf((s + KRSS[row]) * (1.0f / 96.0f) + EPS), rr = r * rk;
                    const int bhk = (row >> 13) * 8 + hh, tk = (row & (SEQ - 1)) >> 6, rwk = row & 63;
#pragma unroll
                    for (int bj = 0; bj < 2; ++bj) *(u32x4*)(KM + kimg(12, bhk, tk, 4 * bj + fq, rwk)) = pack8(acc[ai][bj][m][0] * gg[bj][0] * rr, acc[ai][bj][m][1] * gg[bj][1] * rr);
                    const f32x4 k0 = *(const f32x4*)(KRR + (size_t)row * 32 + 8 * fq), k1 = *(const f32x4*)(KRR + (size_t)row * 32 + 8 * fq + 4);
                    *(u32x4*)(KM + kimg(12, bhk, tk, 8 + fq, rwk)) = pack8(k0 * rk, k1 * rk);
                    asm volatile("" ::: "memory"); }
        }
    }
};

template <bool XI_BF16> struct EpiRes {
    const void* xi; bf16_t* XB; float* SS;
    __device__ __forceinline__ void operator()(const AccT& acc, const pg8::Unit& u, int wr, int wc, int fr, int fq) const {
        const int row0 = u.pm * 256 + wr * 64 + fr, col0 = u.pn * 256 + wc * 32 + 8 * fq;
#pragma unroll
        for (int ai = 0; ai < 2; ++ai) {
            u32x4 rb[4][2]; f32x4 rf[4][2][2];
#pragma unroll
            for (int m = 0; m < 4; ++m) { const size_t off = (size_t)(row0 + ai * 128 + m * 16) * D_MODEL + col0;
#pragma unroll
                for (int bj = 0; bj < 2; ++bj) {
                    if constexpr (XI_BF16) rb[m][bj] = *(const u32x4*)((const bf16_t*)xi + off + bj * 128);
                    else { rf[m][bj][0] = *(const f32x4*)((const float*)xi + off + bj * 128); rf[m][bj][1] = *(const f32x4*)((const float*)xi + off + bj * 128 + 4); } } }
#pragma unroll
            for (int m = 0; m < 4; ++m) { const int row = row0 + ai * 128 + m * 16; const size_t off = (size_t)row * D_MODEL + col0; float s = 0.f;
#pragma unroll
                for (int bj = 0; bj < 2; ++bj) { f32x4 a, b;
                    if constexpr (XI_BF16) { const u32x4 w = rb[m][bj]; a = (f32x4){bflo(w.x), bfhi(w.x), bflo(w.y), bfhi(w.y)}; b = (f32x4){bflo(w.z), bfhi(w.z), bflo(w.w), bfhi(w.w)}; }
                    else { a = rf[m][bj][0]; b = rf[m][bj][1]; }
                    a += acc[ai][bj][m][0]; b += acc[ai][bj][m][1];
                    *(u32x4*)(XB + off + bj * 128) = pack8(a, b); s += sq4(a) + sq4(b); }
                s = red_fq(s); if (fq == 0) SS[(size_t)row * 16 + u.pn * 4 + wc] = s; }
            asm volatile("" ::: "memory"); }
    }
};
__device__ __forceinline__ float rstd_from16(const float* SS, int row, int fq) {
    const f32x4 s4 = *(const f32x4*)(SS + (size_t)row * 16 + 4 * fq); const float s = red_fq((s4[0] + s4[1]) + (s4[2] + s4[3]));
    return rsqrtf(s * (1.0f / 1024.0f) + EPS);
}
struct EpiGate {
    bf16_t* Gt; const float* SS;
    __device__ __forceinline__ void operator()(const AccT& acc, const pg8::Unit& u, int wr, int wc, int fr, int fq) const {
        const int row0 = u.pm * 256 + wr * 64 + fr, col0 = u.pn * 256 + wc * 32 + 8 * fq;
#pragma unroll
        for (int ai = 0; ai < 2; ++ai)
#pragma unroll
            for (int m = 0; m < 4; ++m) { const int row = row0 + ai * 128 + m * 16; const float r = rstd_from16(SS, row, fq);
#pragma unroll
                for (int bj = 0; bj < 2; ++bj) *(u32x4*)(Gt + (size_t)row * D_FF + col0 + bj * 128) = pack8(acc[ai][bj][m][0] * r, acc[ai][bj][m][1] * r); }
    }
};
template <int CTRL> __device__ __forceinline__ unsigned dpp_ror(unsigned v) { return (unsigned)__builtin_amdgcn_update_dpp(0, (int)v, CTRL, 0xf, 0xf, false); }
struct EpiUpAct {
    const bf16_t* Gt; bf16_t* ACT; const float* SS; const float* cw; const float* cb;
    __device__ __forceinline__ void operator()(const AccT& acc, const pg8::Unit& u, int wr, int wc, int fr, int fq) const {
#pragma unroll
        for (int bj = 0; bj < 2; ++bj) { const int col = u.pn * 256 + bj * 128 + wc * 32 + 8 * fq;
            float w0[8], w1[8], w2[8], bb[8];
#pragma unroll
            for (int h = 0; h < 2; ++h) { const f32x4 a = *(const f32x4*)(cw + col + 4 * h), b = *(const f32x4*)(cw + D_FF + col + 4 * h), c = *(const f32x4*)(cw + 2 * D_FF + col + 4 * h), d = *(const f32x4*)(cb + col + 4 * h);
#pragma unroll
                for (int e = 0; e < 4; ++e) { w0[4 * h + e] = a[e]; w1[4 * h + e] = b[e]; w2[4 * h + e] = c[e]; bb[4 * h + e] = d[e]; } }
#pragma unroll
            for (int ai = 0; ai < 2; ++ai) { const int strip0 = u.pm * 256 + ai * 128 + wr * 64;
                const bool seq0 = (strip0 & (SEQ - 1)) == 0;
                u32x4 g[5];
                g[0] = (u32x4){0u, 0u, 0u, 0u};
                if (!seq0) g[0] = *(const u32x4*)(Gt + (size_t)(strip0 - 16 + fr) * D_FF + col);
#pragma unroll
                for (int m = 0; m < 4; ++m) g[m + 1] = *(const u32x4*)(Gt + (size_t)(strip0 + 16 * m + fr) * D_FF + col);
#pragma unroll
                for (int m = 0; m < 4; ++m) { const int row = strip0 + 16 * m + fr; const float r = rstd_from16(SS, row, fq);
                    float uu[8]; { const f32x4 a = acc[ai][bj][m][0] * r, b = acc[ai][bj][m][1] * r;
#pragma unroll
                        for (int e = 0; e < 4; ++e) { uu[e] = a[e]; uu[4 + e] = b[e]; } }
                    float o[8];
#pragma unroll
                    for (int w = 0; w < 4; ++w) { const unsigned x2 = g[m + 1][w];
                        const unsigned x1 = (unsigned)__builtin_amdgcn_update_dpp((int)dpp_ror<0x121>(g[m][w]), (int)g[m + 1][w], 0x111, 0xf, 0xf, false);
                        const unsigned x0 = (unsigned)__builtin_amdgcn_update_dpp((int)dpp_ror<0x122>(g[m][w]), (int)g[m + 1][w], 0x112, 0xf, 0xf, false);
#pragma unroll
                        for (int hh = 0; hh < 2; ++hh) { const int e = 2 * w + hh; const float a0 = hh ? bfhi(x0) : bflo(x0), a1 = hh ? bfhi(x1) : bflo(x1), a2 = hh ? bfhi(x2) : bflo(x2);
                            const float c = bb[e] + w0[e] * a0 + w1[e] * a1 + w2[e] * a2;
                            o[e] = c * __builtin_amdgcn_rcpf(1.0f + __builtin_amdgcn_exp2f(-c * LOG2E)) * uu[e]; } }
                    u32x4 wv; wv.x = cvtpk(o[0], o[1]); wv.y = cvtpk(o[2], o[3]); wv.z = cvtpk(o[4], o[5]); wv.w = cvtpk(o[6], o[7]);
                    *(u32x4*)(ACT + (size_t)row * D_FF + col) = wv; } } }
    }
};
struct EpiBf {
    bf16_t* O;
    __device__ __forceinline__ void operator()(const AccT& acc, const pg8::Unit& u, int wr, int wc, int fr, int fq) const {
        const int row0 = u.pm * 256 + wr * 64 + fr, col0 = u.pn * 256 + wc * 32 + 8 * fq;
#pragma unroll
        for (int ai = 0; ai < 2; ++ai)
#pragma unroll
            for (int m = 0; m < 4; ++m) { const size_t off = (size_t)(row0 + ai * 128 + m * 16) * D_MODEL + col0;
#pragma unroll
                for (int bj = 0; bj < 2; ++bj) *(u32x4*)(O + off + bj * 128) = pack8(acc[ai][bj][m][0], acc[ai][bj][m][1]); }
    }
};
struct EpiPle {
    float* xo; const bf16_t* X2; const bf16_t* PR; const float* SS;
    __device__ __forceinline__ void operator()(const AccT& acc, const pg8::Unit& u, int wr, int wc, int fr, int fq) const {
        const int row0 = u.pm * 256 + wr * 64 + fr, col0 = u.pn * 256 + wc * 32 + 8 * fq;
#pragma unroll
        for (int ai = 0; ai < 2; ++ai) {
            u32x4 xw[4][2], pq[4][2]; float rr[4];
#pragma unroll
            for (int m = 0; m < 4; ++m) { const int row = row0 + ai * 128 + m * 16; const size_t off = (size_t)row * D_MODEL + col0; rr[m] = rstd_from16(SS, row, fq);
#pragma unroll
                for (int bj = 0; bj < 2; ++bj) { xw[m][bj] = *(const u32x4*)(X2 + off + bj * 128); pq[m][bj] = *(const u32x4*)(PR + off + bj * 128); } }
#pragma unroll
            for (int m = 0; m < 4; ++m) { const size_t off = (size_t)(row0 + ai * 128 + m * 16) * D_MODEL + col0; const float r = rr[m];
#pragma unroll
                for (int bj = 0; bj < 2; ++bj) { const size_t o2 = off + bj * 128;
#pragma unroll
                    for (int n = 0; n < 2; ++n) { const unsigned x0 = n ? xw[m][bj].z : xw[m][bj].x, x1 = n ? xw[m][bj].w : xw[m][bj].y, q0 = n ? pq[m][bj].z : pq[m][bj].x, q1 = n ? pq[m][bj].w : pq[m][bj].y;
                        const f32x4 x2 = (f32x4){bflo(x0), bfhi(x0), bflo(x1), bfhi(x1)}, pr = (f32x4){bflo(q0), bfhi(q0), bflo(q1), bfhi(q1)}; const f32x4 gt = acc[ai][bj][m][n] * r; f32x4 o;
#pragma unroll
                        for (int e = 0; e < 4; ++e) o[e] = x2[e] + pr[e] * __builtin_amdgcn_rcpf(1.0f + __builtin_amdgcn_exp2f(-gt[e] * LOG2E));
                        *(f32x4*)(xo + o2 + 4 * n) = o; } } }
            asm volatile("" ::: "memory"); }
    }
};

struct IdleOrder {
    int base, ic, nidle, count, ncol;
    __device__ bool next(int i, pg8::Unit& u) const { const int v = ic + nidle * i; if (ic < 0 || v >= count) return false; const int w = base + v; u.pm = w / ncol; u.pn = w % ncol; return true; }
};
struct PanelOrder {
    int base, ic, per, count;
    __device__ bool next(int i, pg8::Unit& u) const { const int v = per * ic + i; if (i >= per || v >= count) return false; const int w = base + v; u.pm = w >> 2; u.pn = w & 3; return true; }
};
__device__ __forceinline__ void convert_p_rows(const float* p_in, bf16_t* PB, int row0, int nrows, int tid) {
    const size_t e0 = (size_t)row0 * PLE_DIM / 8, n8 = (size_t)nrows * PLE_DIM / 8;
    for (size_t i = tid; i < n8; i += 4 * NWAVES_C * 64) { f32x4 a[4], b[4];
#pragma unroll
        for (int q = 0; q < 4; ++q) { const size_t ii = i + (size_t)q * NWAVES_C * 64; if (ii < n8) { a[q] = *(const GAS f32x4*)(p_in + (e0 + ii) * 8); b[q] = *(const GAS f32x4*)(p_in + (e0 + ii) * 8 + 4); } }
#pragma unroll
        for (int q = 0; q < 4; ++q) { const size_t ii = i + (size_t)q * NWAVES_C * 64; if (ii < n8) *(GAS u32x4*)(PB + (e0 + ii) * 8) = pack8(a[q], b[q]); } }
    asm volatile("s_waitcnt vmcnt(0)" ::: "memory"); __syncthreads();
}

namespace attn {
__device__ __forceinline__ int crow(int r, int hi) { return (r & 3) + 8 * (r >> 2) + 4 * hi; }
__device__ __forceinline__ void glds16(const void* gbase, unsigned voff, unsigned lds_dst) { unsigned keep;
    asm volatile("s_mov_b32 %0, m0\n\ts_mov_b32 m0, %2\n\ts_nop 0\n\tglobal_load_lds_dwordx4 %1, %3\n\ts_mov_b32 m0, %0" : "=&s"(keep) : "v"(voff), "s"(lds_dst), "s"(gbase) : "memory"); }
typedef LAS const char* lds_cptr;
__device__ __forceinline__ s16x4 vtr(lds_cptr p) { return __builtin_bit_cast(s16x4, __builtin_amdgcn_ds_read_tr16_b64_v4i16((LAS s16x4*)p)); }
#define AT_WAITBAR(N) asm volatile("s_waitcnt vmcnt(" #N ") lgkmcnt(0)\n\ts_barrier" ::: "memory")
#define AT_BAR() asm volatile("s_waitcnt lgkmcnt(0)\n\ts_barrier" ::: "memory")
#define AT_WAITBAR_NL(N) asm volatile("s_waitcnt vmcnt(" #N ")\n\ts_barrier" ::: "memory")

template <int NKS, int ND, int NKSL = 3> struct Cfg {
    static constexpr int KSLOT = NKS * 2048, VSLOT = ND * 4096, NCH = NKS * 2;
    static constexpr int LDS_K = 0, LDS_V = NKSL * KSLOT, LDS_WS = LDS_V + 3 * VSLOT, LDS_OST = LDS_WS + 2048, OSTW = ND * 2048, LDS_BIAS = LDS_OST + 8 * OSTW, LDS_END = LDS_BIAS + 4096;
    static constexpr int NKD = (NCH > 8) ? 2 : 1, NVD = (ND * 4) / 8, NDMA = NKD + NVD;
};
struct UnitP { const bf16_t* Q; int ldq; const bf16_t* K; int ldk; const bf16_t* V; int ldv; bf16_t* O; int ldo; int qb; long rowbase; const float* btab; const float* bound; const bf16_t* O1; bf16_t* Yc; const float* gout; const float* lamp; };

constexpr float THR = 8.0f;


template <int NKS, int ND, bool PV, bool QK> struct Ops {
    static constexpr int QCH = NKS / ND, B = (PV ? 4 : 0) + (QK ? 2 * QCH : 0), N = ND * B;
    static_assert(NKS % ND == 0, "k-steps split evenly over the d-blocks");
    __host__ __device__ static constexpr int kind(int i) { return (PV && (i % B) < 4) ? 0 : 1; }
    __host__ __device__ static constexpr int a(int i) { const int blk = i / B, j = i % B; return (PV && j < 4) ? blk : blk * QCH + (j - (PV ? 4 : 0)) / 2; }
    __host__ __device__ static constexpr int b(int i) { const int j = i % B; return (PV && j < 4) ? j : (j - (PV ? 4 : 0)) % 2; }
};
template <int NKS, int ND, bool PV, bool QK>
__device__ __forceinline__ void mfma_slot(f32x16 (&o)[ND], f32x16& p0, f32x16& p1, const u32x4 (&pw)[4], const bf16x8 (&qr)[NKS], const f32x16& negm, lds_cptr kp, lds_cptr vp) {
    typedef Ops<NKS, ND, PV, QK> OP;
    constexpr int AT_D = (ND >= 4) ? 6 : 8;
    s16x4 flo[AT_D], fhi[AT_D];
#define AT_LOAD(i) do { if (OP::kind(i) == 0) { const bf16x8 vv_ = *(const LAS bf16x8*)(vp + OP::a(i) * 4096 + OP::b(i) * 1024); flo[(i) % AT_D] = (s16x4){vv_[0], vv_[1], vv_[2], vv_[3]}; fhi[(i) % AT_D] = (s16x4){vv_[4], vv_[5], vv_[6], vv_[7]}; } \
        else { const bf16x8 kk_ = *(const LAS bf16x8*)(kp + OP::a(i) * 2048 + OP::b(i) * 512); flo[(i) % AT_D] = (s16x4){kk_[0], kk_[1], kk_[2], kk_[3]}; fhi[(i) % AT_D] = (s16x4){kk_[4], kk_[5], kk_[6], kk_[7]}; } } while (0)
#pragma unroll
    for (int i = 0; i < AT_D && i < OP::N; ++i) AT_LOAD(i);
    __builtin_amdgcn_sched_barrier(0);
#pragma unroll
    for (int i = 0; i < OP::N; ++i) {
        const s16x4 lo = flo[i % AT_D], hh = fhi[i % AT_D];
        const bf16x8 f = (bf16x8){lo[0], lo[1], lo[2], lo[3], hh[0], hh[1], hh[2], hh[3]};
        if (OP::kind(i) == 0) o[OP::a(i)] = __builtin_amdgcn_mfma_f32_32x32x16_bf16(__builtin_bit_cast(bf16x8, pw[OP::b(i)]), f, o[OP::a(i)], 0, 0, 0);
        else if (OP::b(i) == 0) p0 = (OP::a(i) == 0) ? __builtin_amdgcn_mfma_f32_32x32x16_bf16(f, qr[0], negm, 0, 0, 0) : __builtin_amdgcn_mfma_f32_32x32x16_bf16(f, qr[OP::a(i)], p0, 0, 0, 0);
        else p1 = (OP::a(i) == 0) ? __builtin_amdgcn_mfma_f32_32x32x16_bf16(f, qr[0], negm, 0, 0, 0) : __builtin_amdgcn_mfma_f32_32x32x16_bf16(f, qr[OP::a(i)], p1, 0, 0, 0);
        if (i + AT_D < OP::N) AT_LOAD(i + AT_D);
        __builtin_amdgcn_sched_barrier(0);
    }

#undef AT_LOAD
}

template <int NKS, int ND, bool MLA>
__device__ __forceinline__ void attn_unit(const UnitP& P, LAS unsigned char* lds, const float* __restrict__ rope, const float* __restrict__ gq) {
    typedef Cfg<NKS, ND> C;
    int tid = threadIdx.x; asm volatile("" : "+v"(tid));
    const int lane = tid & 63, r32 = lane & 31, hi = lane >> 5; const int wid = __builtin_amdgcn_readfirstlane(tid >> 6);
    const int grp = wid >> 2, q0 = P.qb * 256, NT = 4 * P.qb + 4, tmax = 4 * P.qb + (wid >> 1);
    bf16x8 qr[NKS];
    { const bf16_t* Qw = P.Q + (size_t)(P.rowbase + q0 + wid * 32 + r32) * P.ldq + hi * 8;
      if constexpr (MLA) {
        float qf[NKS][8]; float ss = 0.f;
#pragma unroll
        for (int d0 = 0; d0 < NKS; ++d0) { const bf16x8 raw = *(const bf16x8*)(Qw + d0 * 16);
#pragma unroll
            for (int j = 0; j < 8; ++j) { qf[d0][j] = bf2f(raw[j]); ss += qf[d0][j] * qf[d0][j]; } }
        ss += __shfl_xor(ss, 32);
        const float r = rsqrtf(ss * (1.0f / 96.0f) + EPS);
#pragma unroll
        for (int d0 = 0; d0 < NKS; ++d0) { const f32x4 g0 = *(const f32x4*)(gq + 16 * d0 + 8 * hi), g1 = *(const f32x4*)(gq + 16 * d0 + 8 * hi + 4);
#pragma unroll
            for (int j = 0; j < 4; ++j) { qf[d0][j] *= r * g0[j]; qf[d0][4 + j] *= r * g1[j]; } }
        const int pos = q0 + wid * 32 + r32; const float* rp = rope + (size_t)pos * 32 + 8 * hi;
        const f32x4 c0 = *(const f32x4*)rp, c1 = *(const f32x4*)(rp + 4), s0 = *(const f32x4*)(rp + 16), s1 = *(const f32x4*)(rp + 20);
#pragma unroll
        for (int j = 0; j < 8; ++j) { const float c = j < 4 ? c0[j & 3] : c1[j & 3], s = j < 4 ? s0[j & 3] : s1[j & 3]; const float a = qf[4][j], b = qf[5][j]; qf[4][j] = a * c - b * s; qf[5][j] = b * c + a * s; }
        const float sc = 0.10206207261596577f * LOG2E;
#pragma unroll
        for (int d0 = 0; d0 < NKS; ++d0) { u32x4 w; w.x = cvtpk(qf[d0][0] * sc, qf[d0][1] * sc); w.y = cvtpk(qf[d0][2] * sc, qf[d0][3] * sc); w.z = cvtpk(qf[d0][4] * sc, qf[d0][5] * sc); w.w = cvtpk(qf[d0][6] * sc, qf[d0][7] * sc);
            qr[d0] = __builtin_bit_cast(bf16x8, w); }
      } else {
#pragma unroll
        for (int d0 = 0; d0 < NKS; ++d0) qr[d0] = *(const bf16x8*)(Qw + d0 * 16);
      } }
    LAS float* wsf = (LAS float*)(lds + C::LDS_WS) + wid * 64;
    const bool fixed_ref = __builtin_amdgcn_readfirstlane(__float_as_int(*P.bound)) < __float_as_int(64.0f) && *P.bound >= 0.f;
    if constexpr (!MLA) { LAS float* tb = (LAS float*)(lds + C::LDS_BIAS); tb[tid] = P.btab[tid]; tb[tid + 512] = P.btab[tid + 512]; }
    asm volatile("s_waitcnt vmcnt(0)" ::: "memory");
    const unsigned lds0 = (unsigned)(size_t)lds;
    const bf16_t* kbase = P.K; const bf16_t* vbase = P.V;
    const unsigned koff0 = (unsigned)(wid * 1024 + lane * 16), koff1 = (unsigned)((8 + (wid & 3)) * 1024 + lane * 16);
    const unsigned kdst0 = lds0 + C::LDS_K + wid * 1024, kdst1 = lds0 + C::LDS_K + (8 + (wid & 3)) * 1024;
    const unsigned voff0 = (unsigned)(wid * 1024 + lane * 16), voff1 = voff0 + 8192u;
    const unsigned vdst0 = lds0 + C::LDS_V + wid * 1024, vdst1 = vdst0 + 8192;
    const size_t ktile = (size_t)C::KSLOT / 2, vtile = (size_t)C::VSLOT / 2;
#define DMA_K(t, slotoff) do { const bf16_t* kb_ = kbase + (size_t)(t) * ktile; glds16(kb_, koff0, (unsigned)__builtin_amdgcn_readfirstlane(kdst0 + (slotoff))); \
        if constexpr (C::NKD == 2) { if (grp == 0) glds16(kb_, koff1, (unsigned)__builtin_amdgcn_readfirstlane(kdst1 + (slotoff))); } } while (0)
#define DMA_V(t, slotoff) do { const bf16_t* vb_ = vbase + (size_t)(t) * vtile; glds16(vb_, voff0, (unsigned)__builtin_amdgcn_readfirstlane(vdst0 + (slotoff))); \
        if constexpr (C::NVD == 2) glds16(vb_, voff1, (unsigned)__builtin_amdgcn_readfirstlane(vdst1 + (slotoff))); } while (0)
    const lds_cptr kp0 = (lds_cptr)lds + C::LDS_K + hi * 1024 + r32 * 16;
    const lds_cptr vp0 = (lds_cptr)lds + C::LDS_V + lane * 16;
    DMA_K(0, 0); DMA_K(1, C::KSLOT); DMA_V(0, 0);
    static_assert(C::NDMA == 3, "three LDS-DMA pieces per wave per tile");
    if (C::NKD == 2 && grp == 1) { AT_WAITBAR(2); } else { AT_WAITBAR(3); }
    float mhat = 0.f, l_reg = 0.f; f32x16 o[ND]; f32x16 negm = f32x16{}; f32x16 p0 = f32x16{}, p1 = f32x16{}; u32x4 pw[4];
#pragma unroll
    for (int d = 0; d < ND; ++d) o[d] = f32x16{};
#pragma unroll
    for (int k = 0; k < 4; ++k) pw[k] = (u32x4){0u, 0u, 0u, 0u};
#if defined(PROBE_MFMA2)
    f32x16 od_[ND], dp0_ = f32x16{}, dp1_ = f32x16{};
#pragma unroll
    for (int d = 0; d < ND; ++d) od_[d] = f32x16{};
#endif
    int ks0 = 0, ks1 = C::KSLOT, ks2 = 2 * C::KSLOT;
    int vsm = 2 * C::VSLOT, vs0 = 0, vs1 = C::VSLOT;
    if (grp == 1) AT_BAR();
    for (int t = 0; t <= NT; ++t) {
        const bool gk = t + 2 < NT, gv = t + 1 < NT;
        { const bool do_pv = (t >= 1 && t - 1 <= tmax), do_qk = (t < NT && t <= tmax);
          const lds_cptr vp = vp0 + vsm, kp = kp0 + ks0;
          if (do_pv && do_qk) mfma_slot<NKS, ND, true, true>(o, p0, p1, pw, qr, negm, kp, vp);
          else if (do_qk) mfma_slot<NKS, ND, false, true>(o, p0, p1, pw, qr, negm, kp, vp);
          else if (do_pv) mfma_slot<NKS, ND, true, false>(o, p0, p1, pw, qr, negm, kp, vp); }
#if defined(PROBE_MFMA2)
        if constexpr (MLA) { const bool do_pv = (t >= 1 && t - 1 <= tmax), do_qk = (t < NT && t <= tmax); const lds_cptr vp = vp0 + vsm, kp = kp0 + ks0;
          if (do_pv && do_qk) { mfma_slot<NKS, ND, true, true>(od_, dp0_, dp1_, pw, qr, negm, kp, vp); asm volatile("" :: "v"(od_[0]), "v"(od_[1]), "v"(dp0_), "v"(dp1_)); } }
#endif
        if (t == NT) break;
        const int cnt = (gk ? C::NKD : 0) + (gv ? C::NVD : 0);
#define AT_CLOSE() do { if (cnt == 3) { AT_WAITBAR(3); } else if (cnt == 2) { AT_WAITBAR(2); } else if (cnt == 1) { AT_WAITBAR(1); } else { AT_WAITBAR(0); } } while (0)
        if (grp == 1) { AT_WAITBAR(0); } else AT_BAR();
        if (gk) DMA_K(t + 2, ks2);
        if (gv) DMA_V(t + 1, vs1);
        if (t <= tmax) {
            if constexpr (!MLA) {
                const int dmin = q0 + wid * 32 - 64 * t - 63;
                if (dmin < 559) { const LAS float* tb = (const LAS float*)(lds + C::LDS_BIAS) + (dmin + r32 + 63 + 63 - 4 * hi);
#pragma unroll
                    for (int r = 0; r < 16; ++r) { const int kk = (r & 3) + 8 * (r >> 2); p0[r] += tb[-kk]; p1[r] += tb[-kk - 32]; } }
            }
            if (!fixed_ref) {
            float a = fmaxf(fmaxf(p0[0], p0[1]), p1[0]), b = fmaxf(fmaxf(p0[2], p0[3]), p1[1]); a = fmaxf(fmaxf(a, p1[2]), p1[3]);
#pragma unroll
            for (int r = 4; r < 16; r += 4) { a = fmaxf(fmaxf(a, p0[r]), p0[r + 1]); b = fmaxf(fmaxf(b, p0[r + 2]), p0[r + 3]); a = fmaxf(fmaxf(a, p1[r]), p1[r + 1]); b = fmaxf(fmaxf(b, p1[r + 2]), p1[r + 3]); }
            float rm = fmaxf(a, b); { auto rr = __builtin_amdgcn_permlane32_swap(__float_as_uint(rm), __float_as_uint(rm), false, false); rm = fmaxf(__uint_as_float(rr[0]), __uint_as_float(rr[1])); }
            if (t == 0 || __any(rm > THR)) {
                const float dl = (t == 0) ? rm : fmaxf(rm, 0.f); mhat += dl;
#pragma unroll
                for (int r = 0; r < 16; ++r) { p0[r] -= dl; p1[r] -= dl; }
#pragma unroll
                for (int r = 0; r < 16; ++r) negm[r] = -mhat;
                if (t != 0) { const float f = __builtin_amdgcn_exp2f(-dl); l_reg *= f; if (hi == 0) wsf[r32] = f;
                    asm volatile("s_waitcnt lgkmcnt(0)" ::: "memory");
#pragma unroll
                    for (int r = 0; r < 16; ++r) { const float fr_ = wsf[crow(r, hi)];
#pragma unroll
                        for (int d = 0; d < ND; ++d) o[d][r] *= fr_; } }
            }
            }
            float sacc = 0.f;
#pragma unroll
            for (int r = 0; r < 16; ++r) { p0[r] = __builtin_amdgcn_exp2f(p0[r]); p1[r] = __builtin_amdgcn_exp2f(p1[r]); sacc += p0[r] + p1[r]; }
            l_reg += sacc;
#if defined(PROBE_SM2)
            if constexpr (MLA) { float dsum_ = 0.f;
#pragma unroll
                for (int r = 0; r < 16; ++r) { dsum_ += __builtin_amdgcn_exp2f(p0[r] - 1.0f) + __builtin_amdgcn_exp2f(p1[r] - 1.0f); }
                asm volatile("" :: "v"(dsum_)); }
#endif
            pw[0] = (u32x4){cvtpk(p0[0], p0[1]), cvtpk(p0[2], p0[3]), cvtpk(p0[4], p0[5]), cvtpk(p0[6], p0[7])};
            pw[1] = (u32x4){cvtpk(p0[8], p0[9]), cvtpk(p0[10], p0[11]), cvtpk(p0[12], p0[13]), cvtpk(p0[14], p0[15])};
            pw[2] = (u32x4){cvtpk(p1[0], p1[1]), cvtpk(p1[2], p1[3]), cvtpk(p1[4], p1[5]), cvtpk(p1[6], p1[7])};
            pw[3] = (u32x4){cvtpk(p1[8], p1[9]), cvtpk(p1[10], p1[11]), cvtpk(p1[12], p1[13]), cvtpk(p1[14], p1[15])};
        }
        if (grp == 0) AT_CLOSE(); else AT_BAR();
        { const int k_ = ks0; ks0 = ks1; ks1 = ks2; ks2 = k_; const int v_ = vsm; vsm = vs0; vs0 = vs1; vs1 = v_; }
    }
    if (grp == 0) AT_BAR();
    { auto rr = __builtin_amdgcn_permlane32_swap(__float_as_uint(l_reg), __float_as_uint(l_reg), false, false); l_reg = __uint_as_float(rr[0]) + __uint_as_float(rr[1]); }
    if (hi == 0) wsf[32 + r32] = l_reg;
    asm volatile("s_waitcnt lgkmcnt(0)" ::: "memory");
    { int le = lane; asm volatile("" : "+v"(le));
      const int r32e = le & 31, hie = le >> 5;
      LAS bf16_t* stg = (LAS bf16_t*)(lds + C::LDS_OST + wid * C::OSTW);
      constexpr int RW = ND * 32;
#pragma unroll
      for (int r = 0; r < 16; ++r) { const int orow = (r & 3) + 8 * (r >> 2); const float rl = __builtin_amdgcn_rcpf(wsf[32 + 4 * hie + orow]);
#pragma unroll
          for (int d0 = 0; d0 < ND; ++d0) { const unsigned w = cvtpk(o[d0][r] * rl, 0.f); stg[(4 * hie + r32e) + orow * RW + d0 * 32 + (RW - 1) * 4 * hie] = (bf16_t)(w & 0xffffu); } }
      asm volatile("s_waitcnt lgkmcnt(0)" ::: "memory");
      constexpr int CPR = ND * 4, RPI = 64 / CPR;
      const int rowl = le / CPR, ch = le % CPR;
      const LAS bf16_t* sp = stg + rowl * RW + ch * 8;
      bf16_t* Ow = P.O + (size_t)(P.rowbase + q0 + wid * 32 + rowl) * P.ldo + ch * 8;
      if (MLA || P.O1 == nullptr) {
#pragma unroll
          for (int i = 0; i < ND * 2; ++i) { const u32x4 v = *(const LAS u32x4*)(sp + i * RPI * RW); *(u32x4*)(Ow + (size_t)(i * RPI) * P.ldo) = v; }
      } else {
          const float lam = *P.lamp; const f32x4 g0 = *(const f32x4*)(P.gout + ch * 8) * 0.8f, g1 = *(const f32x4*)(P.gout + ch * 8 + 4) * 0.8f;
          const bf16_t* O1p = P.O1 + (size_t)(P.rowbase + q0 + wid * 32 + rowl) * 1024 + ch * 8; bf16_t* Yp = P.Yc + (size_t)(P.rowbase + q0 + wid * 32 + rowl) * 1024 + ch * 8;
#pragma unroll
          for (int i = 0; i < ND * 2; ++i) { const u32x4 v2 = *(const LAS u32x4*)(sp + i * RPI * RW); const u32x4 v1 = *(const u32x4*)(O1p + (size_t)(i * RPI) * 1024);
              f32x4 a = (f32x4){bflo(v1.x) - lam * bflo(v2.x), bfhi(v1.x) - lam * bfhi(v2.x), bflo(v1.y) - lam * bflo(v2.y), bfhi(v1.y) - lam * bfhi(v2.y)};
              f32x4 b = (f32x4){bflo(v1.z) - lam * bflo(v2.z), bfhi(v1.z) - lam * bfhi(v2.z), bflo(v1.w) - lam * bflo(v2.w), bfhi(v1.w) - lam * bfhi(v2.w)};
              float ss = sq4(a) + sq4(b); ss += __shfl_xor(ss, 1); ss += __shfl_xor(ss, 2); ss += __shfl_xor(ss, 4); ss += __shfl_xor(ss, 8);
              const float r = rsqrtf(ss * (1.0f / 128.0f) + EPS);
              *(u32x4*)(Yp + (size_t)(i * RPI) * 1024) = pack8(a * g0 * r, b * g1 * r); }
      } }
    AT_BAR();
#undef DMA_K
#undef DMA_V
#undef AT_CLOSE
}

template <int NKS, int ND, bool MLA>
__device__ __forceinline__ void attn_unit_iw(const UnitP& P, LAS unsigned char* lds, const float* __restrict__ rope, const float* __restrict__ gq) {
    typedef Cfg<NKS, ND, 4> C;
    int tid = threadIdx.x; asm volatile("" : "+v"(tid));
    const int lane = tid & 63, r32 = lane & 31, hi = lane >> 5; const int wid = __builtin_amdgcn_readfirstlane(tid >> 6);
    const int grp = wid >> 2, q0 = P.qb * 256, NT = 4 * P.qb + 4, tmax = 4 * P.qb + (wid >> 1);
    bf16x8 qr[NKS];
    { const bf16_t* Qw = P.Q + (size_t)(P.rowbase + q0 + wid * 32 + r32) * P.ldq + hi * 8;
      if constexpr (MLA) {
        float qf[NKS][8]; float ss = 0.f;
#pragma unroll
        for (int d0 = 0; d0 < NKS; ++d0) { const bf16x8 raw = *(const bf16x8*)(Qw + d0 * 16);
#pragma unroll
            for (int j = 0; j < 8; ++j) { qf[d0][j] = bf2f(raw[j]); ss += qf[d0][j] * qf[d0][j]; } }
        ss += __shfl_xor(ss, 32);
        const float r = rsqrtf(ss * (1.0f / 96.0f) + EPS);
#pragma unroll
        for (int d0 = 0; d0 < NKS; ++d0) { const f32x4 g0 = *(const f32x4*)(gq + 16 * d0 + 8 * hi), g1 = *(const f32x4*)(gq + 16 * d0 + 8 * hi + 4);
#pragma unroll
            for (int j = 0; j < 4; ++j) { qf[d0][j] *= r * g0[j]; qf[d0][4 + j] *= r * g1[j]; } }
        const int pos = q0 + wid * 32 + r32; const float* rp = rope + (size_t)pos * 32 + 8 * hi;
        const f32x4 c0 = *(const f32x4*)rp, c1 = *(const f32x4*)(rp + 4), s0 = *(const f32x4*)(rp + 16), s1 = *(const f32x4*)(rp + 20);
#pragma unroll
        for (int j = 0; j < 8; ++j) { const float c = j < 4 ? c0[j & 3] : c1[j & 3], s = j < 4 ? s0[j & 3] : s1[j & 3]; const float a = qf[4][j], b = qf[5][j]; qf[4][j] = a * c - b * s; qf[5][j] = b * c + a * s; }
        const float sc = 0.10206207261596577f * LOG2E;
#pragma unroll
        for (int d0 = 0; d0 < NKS; ++d0) { u32x4 w; w.x = cvtpk(qf[d0][0] * sc, qf[d0][1] * sc); w.y = cvtpk(qf[d0][2] * sc, qf[d0][3] * sc); w.z = cvtpk(qf[d0][4] * sc, qf[d0][5] * sc); w.w = cvtpk(qf[d0][6] * sc, qf[d0][7] * sc);
            qr[d0] = __builtin_bit_cast(bf16x8, w); }
      } else {
#pragma unroll
        for (int d0 = 0; d0 < NKS; ++d0) qr[d0] = *(const bf16x8*)(Qw + d0 * 16);
      } }
    LAS float* wsf = (LAS float*)(lds + C::LDS_WS) + wid * 64;
    const bool fixed_ref = __builtin_amdgcn_readfirstlane(__float_as_int(*P.bound)) < __float_as_int(64.0f) && *P.bound >= 0.f;
    if constexpr (!MLA) { LAS float* tb = (LAS float*)(lds + C::LDS_BIAS); tb[tid] = P.btab[tid]; tb[tid + 512] = P.btab[tid + 512]; }
    asm volatile("s_waitcnt vmcnt(0)" ::: "memory");
    const unsigned lds0 = (unsigned)(size_t)lds;
    const bf16_t* kbase = P.K; const bf16_t* vbase = P.V;
    const unsigned koff0 = (unsigned)(wid * 1024 + lane * 16), koff1 = (unsigned)((8 + (wid & 3)) * 1024 + lane * 16);
    const unsigned kdst0 = lds0 + C::LDS_K + wid * 1024, kdst1 = lds0 + C::LDS_K + (8 + (wid & 3)) * 1024;
    const unsigned voff0 = (unsigned)(wid * 1024 + lane * 16), voff1 = voff0 + 8192u;
    const unsigned vdst0 = lds0 + C::LDS_V + wid * 1024, vdst1 = vdst0 + 8192;
    const size_t ktile = (size_t)C::KSLOT / 2, vtile = (size_t)C::VSLOT / 2;
#define DMA_K(t, slotoff) do { const bf16_t* kb_ = kbase + (size_t)(t) * ktile; glds16(kb_, koff0, (unsigned)__builtin_amdgcn_readfirstlane(kdst0 + (slotoff))); \
        if constexpr (C::NKD == 2) glds16(kb_, koff1, (unsigned)__builtin_amdgcn_readfirstlane(kdst1 + (slotoff))); } while (0)
#define DMA_V(t, slotoff) do { const bf16_t* vb_ = vbase + (size_t)(t) * vtile; glds16(vb_, voff0, (unsigned)__builtin_amdgcn_readfirstlane(vdst0 + (slotoff))); \
        if constexpr (C::NVD == 2) glds16(vb_, voff1, (unsigned)__builtin_amdgcn_readfirstlane(vdst1 + (slotoff))); } while (0)
    const lds_cptr kp0 = (lds_cptr)lds + C::LDS_K + hi * 1024 + r32 * 16;
    const lds_cptr vp0 = (lds_cptr)lds + C::LDS_V + lane * 16;
    DMA_K(0, 0); DMA_K(1, C::KSLOT); DMA_K(2, 2 * C::KSLOT); DMA_V(0, 0);
    static_assert(C::NDMA == 3, "three LDS-DMA pieces per wave per tile");
    AT_WAITBAR(3);
    float l_reg = 0.f; f32x16 o[ND]; f32x16 pA0, pA1, pB0, pB1; u32x4 pw[4];
#pragma unroll
    for (int d = 0; d < ND; ++d) o[d] = f32x16{};
#pragma unroll
    for (int k = 0; k < 4; ++k) pw[k] = (u32x4){0u, 0u, 0u, 0u};
    int ks0 = 0, ks1 = C::KSLOT, ks2 = 2 * C::KSLOT, ks3 = 3 * C::KSLOT;
    s16x4 flo[(ND >= 4) ? 6 : 8], fhi[(ND >= 4) ? 6 : 8];
    int vsm = 2 * C::VSLOT, vs0 = 0, vs1 = C::VSLOT;
    (void)grp; (void)fixed_ref; (void)wsf;
    constexpr int NQK = 2 * NKS, NPV = 4 * ND, NOPS = NQK + NPV, WD = 6;
    constexpr int FA = (32 + NQK - 1) / NQK, FP = (16 + NQK - 1) / NQK, FE = 32 / NPV;
    static_assert(32 % NPV == 0, "exps split evenly over the P.V gaps");
#define PE(P0_, P1_, e_) (((e_) < 16) ? P0_[(e_) & 15] : P1_[(e_) & 15])
#define W_LOAD(i_) do { if ((i_) < NQK) { const bf16x8 kk_ = *(const LAS bf16x8*)(kp_ + ((i_) / 2) * 2048 + ((i_) % 2) * 512); flo[(i_) % WD] = (s16x4){kk_[0], kk_[1], kk_[2], kk_[3]}; fhi[(i_) % WD] = (s16x4){kk_[4], kk_[5], kk_[6], kk_[7]}; } \
        else { const bf16x8 vv_ = *(const LAS bf16x8*)(vp_ + (((i_) - NQK) / 4) * 4096 + (((i_) - NQK) % 4) * 1024); flo[(i_) % WD] = (s16x4){vv_[0], vv_[1], vv_[2], vv_[3]}; fhi[(i_) % WD] = (s16x4){vv_[4], vv_[5], vv_[6], vv_[7]}; } } while (0)
#define W_FRAG(i_) ((bf16x8){flo[(i_) % WD][0], flo[(i_) % WD][1], flo[(i_) % WD][2], flo[(i_) % WD][3], fhi[(i_) % WD][0], fhi[(i_) % WD][1], fhi[(i_) % WD][2], fhi[(i_) % WD][3]})
#define ISSUE_DMA(t_) do { if ((t_) + 3 < NT) DMA_K((t_) + 3, ks3); if ((t_) + 1 < NT) DMA_V((t_) + 1, vs1); } while (0)
#define PREFILL(t_) do { if ((t_) + 1 <= tmax) { const lds_cptr kn_ = kp0 + ks1; _Pragma("unroll") for (int i = 0; i < WD; ++i) { const bf16x8 kk_ = *(const LAS bf16x8*)(kn_ + (i / 2) * 2048 + (i % 2) * 512); flo[i] = (s16x4){kk_[0], kk_[1], kk_[2], kk_[3]}; fhi[i] = (s16x4){kk_[4], kk_[5], kk_[6], kk_[7]}; } } } while (0)
#define BIAS(C0_, C1_, t_) do { if constexpr (!MLA) { const int dmin_ = q0 + wid * 32 - 64 * (t_) - 63; \
        if (dmin_ < 559) { const LAS float* tb_ = (const LAS float*)(lds + C::LDS_BIAS) + (dmin_ + r32 + 126 - 4 * hi); \
            _Pragma("unroll") for (int r = 0; r < 16; ++r) { const int kk_ = (r & 3) + 8 * (r >> 2); C0_[r] += tb_[-kk_]; C1_[r] += tb_[-kk_ - 32]; } } } } while (0)
#define SUMPACK_ALL(P0_, P1_) do { float sa_ = 0.f; _Pragma("unroll") for (int e = 0; e < 32; ++e) sa_ += PE(P0_, P1_, e); l_reg += sa_; \
        _Pragma("unroll") for (int w = 0; w < 16; ++w) pw[w / 4][w % 4] = cvtpk(PE(P0_, P1_, 2 * w), PE(P0_, P1_, 2 * w + 1)); } while (0)
#define STEP(C0_, C1_, P0_, P1_, t_) do { \
        const lds_cptr kp_ = kp0 + ks0, vp_ = vp0 + vsm; \
        __builtin_amdgcn_sched_barrier(0); \
        float sacc_ = 0.f; \
        _Pragma("unroll") for (int g = 0; g < NQK; ++g) { const bf16x8 f_ = W_FRAG(g); \
            if ((g & 1) == 0) C0_ = (g / 2 == 0) ? __builtin_amdgcn_mfma_f32_32x32x16_bf16(f_, qr[0], (f32x16){}, 0, 0, 0) : __builtin_amdgcn_mfma_f32_32x32x16_bf16(f_, qr[g / 2], C0_, 0, 0, 0); \
            else C1_ = (g / 2 == 0) ? __builtin_amdgcn_mfma_f32_32x32x16_bf16(f_, qr[0], (f32x16){}, 0, 0, 0) : __builtin_amdgcn_mfma_f32_32x32x16_bf16(f_, qr[g / 2], C1_, 0, 0, 0); \
            if (g + WD < NOPS) W_LOAD(g + WD); \
            _Pragma("unroll") for (int j = 0; j < FA; ++j) { if (g * FA + j < 32) sacc_ += PE(P0_, P1_, (g * FA + j) & 31); } \
            _Pragma("unroll") for (int j = 0; j < FP; ++j) { if (g * FP + j < 16) { unsigned pk_ = cvtpk(PE(P0_, P1_, (2 * (g * FP + j)) & 31), PE(P0_, P1_, (2 * (g * FP + j) + 1) & 31)); asm volatile("" : "+v"(pk_)); pw[((g * FP + j) & 15) / 4][(g * FP + j) % 4] = pk_; } } \
            asm volatile("" : "+v"(sacc_)); \
            if (g == 1) { if ((t_) + 3 < NT) DMA_K((t_) + 3, ks3); } \
            if (g == 5) { if ((t_) + 1 < NT) DMA_V((t_) + 1, vs1); } \
            __builtin_amdgcn_sched_barrier(0); } \
        l_reg += sacc_; \
        BIAS(C0_, C1_, t_); \
        __builtin_amdgcn_sched_barrier(0); \
        _Pragma("unroll") for (int h = 0; h < NPV; ++h) { const bf16x8 f_ = W_FRAG(NQK + h); \
            o[h / 4] = __builtin_amdgcn_mfma_f32_32x32x16_bf16(__builtin_bit_cast(bf16x8, pw[h % 4]), f_, o[h / 4], 0, 0, 0); \
            if (NQK + h + WD < NOPS) W_LOAD(NQK + h + WD); \
            _Pragma("unroll") for (int j = 0; j < FE; ++j) { if (h * FE + j < 16) C0_[(h * FE + j) & 15] = __builtin_amdgcn_exp2f(C0_[(h * FE + j) & 15]); else C1_[(h * FE + j) & 15] = __builtin_amdgcn_exp2f(C1_[(h * FE + j) & 15]); } \
            if (h * FE < 16) asm volatile("" : "+v"(C0_)); else asm volatile("" : "+v"(C1_)); \
            __builtin_amdgcn_sched_barrier(0); } \
        PREFILL(t_); \
    } while (0)
#define DRAIN(P0_, P1_) do { SUMPACK_ALL(P0_, P1_); f32x16 d0_ = f32x16{}, d1_ = f32x16{}; const f32x16 z_ = f32x16{}; mfma_slot<NKS, ND, true, false>(o, d0_, d1_, pw, qr, z_, kp0 + ks0, vp0 + vsm); } while (0)
#define AT_CLOSE(t_) do { const int cnt_ = (((t_) + 3 < NT) ? C::NKD : 0) + (((t_) + 1 < NT) ? C::NVD : 0); \
        if (cnt_ == 3) { AT_WAITBAR_NL(3); } else if (cnt_ == 2) { AT_WAITBAR_NL(2); } else if (cnt_ == 1) { AT_WAITBAR_NL(1); } else { AT_WAITBAR_NL(0); } } while (0)
#define ROTATE() do { const int k_ = ks0; ks0 = ks1; ks1 = ks2; ks2 = ks3; ks3 = k_; const int v_ = vsm; vsm = vs0; vs0 = vs1; vs1 = v_; } while (0)
#define SLOT(C0_, C1_, P0_, P1_, t_) do { if ((t_) <= tmax) { STEP(C0_, C1_, P0_, P1_, t_); } else { ISSUE_DMA(t_); if ((t_) == tmax + 1) { DRAIN(P0_, P1_); } } AT_CLOSE(t_); ROTATE(); } while (0)
    { ISSUE_DMA(0);
      const f32x16 z_ = f32x16{};
      mfma_slot<NKS, ND, false, true>(o, pA0, pA1, pw, qr, z_, kp0 + ks0, vp0 + vsm);
      BIAS(pA0, pA1, 0);
#pragma unroll
      for (int r = 0; r < 16; ++r) { pA0[r] = __builtin_amdgcn_exp2f(pA0[r]); pA1[r] = __builtin_amdgcn_exp2f(pA1[r]); }
      PREFILL(0);
      AT_CLOSE(0); ROTATE(); }
    int t = 1; const int tlast = tmax < NT - 1 ? tmax : NT - 1;
#pragma unroll 1
    for (; t + 1 <= tlast; t += 2) {
        STEP(pB0, pB1, pA0, pA1, t); AT_CLOSE(t); ROTATE();
        STEP(pA0, pA1, pB0, pB1, t + 1); AT_CLOSE(t + 1); ROTATE();
    }
    if (t <= tlast) { STEP(pB0, pB1, pA0, pA1, t); AT_CLOSE(t); ROTATE(); pA0 = pB0; pA1 = pB1; ++t; }
    if (t < NT) { ISSUE_DMA(t); DRAIN(pA0, pA1); AT_CLOSE(t); ROTATE(); ++t; }
#pragma unroll 1
    for (; t < NT; ++t) { ISSUE_DMA(t); AT_CLOSE(t); ROTATE(); }
    if (tmax == NT - 1) { DRAIN(pA0, pA1); }
#undef PE
#undef W_LOAD
#undef W_FRAG
#undef ISSUE_DMA
#undef PREFILL
#undef BIAS
#undef SUMPACK_ALL
#undef STEP
#undef DRAIN
#undef ROTATE
#undef SLOT
    { auto rr = __builtin_amdgcn_permlane32_swap(__float_as_uint(l_reg), __float_as_uint(l_reg), false, false); l_reg = __uint_as_float(rr[0]) + __uint_as_float(rr[1]); }
    if (hi == 0) wsf[32 + r32] = l_reg;
    asm volatile("s_waitcnt lgkmcnt(0)" ::: "memory");
    { int le = lane; asm volatile("" : "+v"(le));
      const int r32e = le & 31, hie = le >> 5;
      LAS bf16_t* stg = (LAS bf16_t*)(lds + C::LDS_OST + wid * C::OSTW);
      constexpr int RW = ND * 32;
#pragma unroll
      for (int r = 0; r < 16; ++r) { const int orow = (r & 3) + 8 * (r >> 2); const float rl = __builtin_amdgcn_rcpf(wsf[32 + 4 * hie + orow]);
#pragma unroll
          for (int d0 = 0; d0 < ND; ++d0) { const unsigned w = cvtpk(o[d0][r] * rl, 0.f); stg[(4 * hie + r32e) + orow * RW + d0 * 32 + (RW - 1) * 4 * hie] = (bf16_t)(w & 0xffffu); } }
      asm volatile("s_waitcnt lgkmcnt(0)" ::: "memory");
      constexpr int CPR = ND * 4, RPI = 64 / CPR;
      const int rowl = le / CPR, ch = le % CPR;
      const LAS bf16_t* sp = stg + rowl * RW + ch * 8;
      bf16_t* Ow = P.O + (size_t)(P.rowbase + q0 + wid * 32 + rowl) * P.ldo + ch * 8;
      if (MLA || P.O1 == nullptr) {
#pragma unroll
          for (int i = 0; i < ND * 2; ++i) { const u32x4 v = *(const LAS u32x4*)(sp + i * RPI * RW); *(u32x4*)(Ow + (size_t)(i * RPI) * P.ldo) = v; }
      } else {
          const float lam = *P.lamp; const f32x4 g0 = *(const f32x4*)(P.gout + ch * 8) * 0.8f, g1 = *(const f32x4*)(P.gout + ch * 8 + 4) * 0.8f;
          const bf16_t* O1p = P.O1 + (size_t)(P.rowbase + q0 + wid * 32 + rowl) * 1024 + ch * 8; bf16_t* Yp = P.Yc + (size_t)(P.rowbase + q0 + wid * 32 + rowl) * 1024 + ch * 8;
#pragma unroll
          for (int i = 0; i < ND * 2; ++i) { const u32x4 v2 = *(const LAS u32x4*)(sp + i * RPI * RW); const u32x4 v1 = *(const u32x4*)(O1p + (size_t)(i * RPI) * 1024);
              f32x4 a = (f32x4){bflo(v1.x) - lam * bflo(v2.x), bfhi(v1.x) - lam * bfhi(v2.x), bflo(v1.y) - lam * bflo(v2.y), bfhi(v1.y) - lam * bfhi(v2.y)};
              f32x4 b = (f32x4){bflo(v1.z) - lam * bflo(v2.z), bfhi(v1.z) - lam * bfhi(v2.z), bflo(v1.w) - lam * bflo(v2.w), bfhi(v1.w) - lam * bfhi(v2.w)};
              float ss = sq4(a) + sq4(b); ss += __shfl_xor(ss, 1); ss += __shfl_xor(ss, 2); ss += __shfl_xor(ss, 4); ss += __shfl_xor(ss, 8);
              const float r = rsqrtf(ss * (1.0f / 128.0f) + EPS);
              *(u32x4*)(Yp + (size_t)(i * RPI) * 1024) = pack8(a * g0 * r, b * g1 * r); }
      } }
    AT_BAR();
#undef DMA_K
#undef DMA_V
#undef AT_CLOSE
}

template <int NKS, int ND, bool MLA>
__device__ __forceinline__ void attn_unit_iw2(const UnitP& P, LAS unsigned char* lds, const float* __restrict__ rope, const float* __restrict__ gq) {
    typedef Cfg<NKS, ND, 4> C;
    int tid = threadIdx.x; asm volatile("" : "+v"(tid));
    const int lane = tid & 63, r32 = lane & 31, hi = lane >> 5; const int wid = __builtin_amdgcn_readfirstlane(tid >> 6);
    const int grp = wid >> 2, q0 = P.qb * 256, NT = 4 * P.qb + 4, tmax = 4 * P.qb + (wid >> 1);
    bf16x8 qr[NKS];
    { const bf16_t* Qw = P.Q + (size_t)(P.rowbase + q0 + wid * 32 + r32) * P.ldq + hi * 8;
      if constexpr (MLA) {
        float qf[NKS][8]; float ss = 0.f;
#pragma unroll
        for (int d0 = 0; d0 < NKS; ++d0) { const bf16x8 raw = *(const bf16x8*)(Qw + d0 * 16);
#pragma unroll
            for (int j = 0; j < 8; ++j) { qf[d0][j] = bf2f(raw[j]); ss += qf[d0][j] * qf[d0][j]; } }
        ss += __shfl_xor(ss, 32);
        const float r = rsqrtf(ss * (1.0f / 96.0f) + EPS);
#pragma unroll
        for (int d0 = 0; d0 < NKS; ++d0) { const f32x4 g0 = *(const f32x4*)(gq + 16 * d0 + 8 * hi), g1 = *(const f32x4*)(gq + 16 * d0 + 8 * hi + 4);
#pragma unroll
            for (int j = 0; j < 4; ++j) { qf[d0][j] *= r * g0[j]; qf[d0][4 + j] *= r * g1[j]; } }
        const int pos = q0 + wid * 32 + r32; const float* rp = rope + (size_t)pos * 32 + 8 * hi;
        const f32x4 c0 = *(const f32x4*)rp, c1 = *(const f32x4*)(rp + 4), s0 = *(const f32x4*)(rp + 16), s1 = *(const f32x4*)(rp + 20);
#pragma unroll
        for (int j = 0; j < 8; ++j) { const float c = j < 4 ? c0[j & 3] : c1[j & 3], s = j < 4 ? s0[j & 3] : s1[j & 3]; const float a = qf[4][j], b = qf[5][j]; qf[4][j] = a * c - b * s; qf[5][j] = b * c + a * s; }
        const float sc = 0.10206207261596577f * LOG2E;
#pragma unroll
        for (int d0 = 0; d0 < NKS; ++d0) { u32x4 w; w.x = cvtpk(qf[d0][0] * sc, qf[d0][1] * sc); w.y = cvtpk(qf[d0][2] * sc, qf[d0][3] * sc); w.z = cvtpk(qf[d0][4] * sc, qf[d0][5] * sc); w.w = cvtpk(qf[d0][6] * sc, qf[d0][7] * sc);
            qr[d0] = __builtin_bit_cast(bf16x8, w); }
      } else {
#pragma unroll
        for (int d0 = 0; d0 < NKS; ++d0) qr[d0] = *(const bf16x8*)(Qw + d0 * 16);
      } }
    LAS float* wsf = (LAS float*)(lds + C::LDS_WS) + wid * 64;
    const bool fixed_ref = __builtin_amdgcn_readfirstlane(__float_as_int(*P.bound)) < __float_as_int(64.0f) && *P.bound >= 0.f;
    if constexpr (!MLA) { LAS float* tb = (LAS float*)(lds + C::LDS_BIAS); tb[tid] = P.btab[tid]; tb[tid + 512] = P.btab[tid + 512]; }
    asm volatile("s_waitcnt vmcnt(0)" ::: "memory");
    const unsigned lds0 = (unsigned)(size_t)lds;
    const bf16_t* kbase = P.K; const bf16_t* vbase = P.V;
    const unsigned koff0 = (unsigned)(wid * 1024 + lane * 16), koff1 = (unsigned)((8 + (wid & 3)) * 1024 + lane * 16);
    const unsigned kdst0 = lds0 + C::LDS_K + wid * 1024, kdst1 = lds0 + C::LDS_K + (8 + (wid & 3)) * 1024;
    const unsigned voff0 = (unsigned)(wid * 1024 + lane * 16), voff1 = voff0 + 8192u;
    const unsigned vdst0 = lds0 + C::LDS_V + wid * 1024, vdst1 = vdst0 + 8192;
    const size_t ktile = (size_t)C::KSLOT / 2, vtile = (size_t)C::VSLOT / 2;
#define DMA_K(t, slotoff) do { const bf16_t* kb_ = kbase + (size_t)(t) * ktile; glds16(kb_, koff0, (unsigned)__builtin_amdgcn_readfirstlane(kdst0 + (slotoff))); \
        if constexpr (C::NKD == 2) glds16(kb_, koff1, (unsigned)__builtin_amdgcn_readfirstlane(kdst1 + (slotoff))); } while (0)
#define DMA_V(t, slotoff) do { const bf16_t* vb_ = vbase + (size_t)(t) * vtile; glds16(vb_, voff0, (unsigned)__builtin_amdgcn_readfirstlane(vdst0 + (slotoff))); \
        if constexpr (C::NVD == 2) glds16(vb_, voff1, (unsigned)__builtin_amdgcn_readfirstlane(vdst1 + (slotoff))); } while (0)
    const lds_cptr kp0 = (lds_cptr)lds + C::LDS_K + hi * 1024 + r32 * 16;
    const lds_cptr vp0 = (lds_cptr)lds + C::LDS_V + lane * 16;
    DMA_K(0, 0); DMA_K(1, C::KSLOT); DMA_K(2, 2 * C::KSLOT); DMA_V(0, 0);
    static_assert(C::NDMA == 3, "three LDS-DMA pieces per wave per tile");
    AT_WAITBAR(3);
    float l_reg = 0.f; f32x16 o[ND]; f32x16 c0, c1; u32x4 pwc[4], pwn[4];
#pragma unroll
    for (int d = 0; d < ND; ++d) o[d] = f32x16{};
#pragma unroll
    for (int k = 0; k < 4; ++k) { pwc[k] = (u32x4){0u, 0u, 0u, 0u}; pwn[k] = (u32x4){0u, 0u, 0u, 0u}; }
    int ks0 = 0, ks1 = C::KSLOT, ks2 = 2 * C::KSLOT, ks3 = 3 * C::KSLOT;
    s16x4 flo[(ND >= 4) ? 6 : 8], fhi[(ND >= 4) ? 6 : 8];
    int vsm = 2 * C::VSLOT, vs0 = 0, vs1 = C::VSLOT;
    (void)grp; (void)fixed_ref; (void)wsf;
    constexpr int NQK = 2 * NKS, NPV = 4 * ND, NOPS = NQK + NPV, WD = 6;
    static_assert(NPV == 16, "one bf16 pack word per P.V gap");
#define CE(e_) (((e_) < 16) ? c0[(e_) & 15] : c1[(e_) & 15])
#define W_LOAD(i_) do { if ((i_) < NQK) { const bf16x8 kk_ = *(const LAS bf16x8*)(kp_ + ((i_) / 2) * 2048 + ((i_) % 2) * 512); flo[(i_) % WD] = (s16x4){kk_[0], kk_[1], kk_[2], kk_[3]}; fhi[(i_) % WD] = (s16x4){kk_[4], kk_[5], kk_[6], kk_[7]}; } \
        else { const bf16x8 vv_ = *(const LAS bf16x8*)(vp_ + (((i_) - NQK) / 4) * 4096 + (((i_) - NQK) % 4) * 1024); flo[(i_) % WD] = (s16x4){vv_[0], vv_[1], vv_[2], vv_[3]}; fhi[(i_) % WD] = (s16x4){vv_[4], vv_[5], vv_[6], vv_[7]}; } } while (0)
#define W_FRAG(i_) ((bf16x8){flo[(i_) % WD][0], flo[(i_) % WD][1], flo[(i_) % WD][2], flo[(i_) % WD][3], fhi[(i_) % WD][0], fhi[(i_) % WD][1], fhi[(i_) % WD][2], fhi[(i_) % WD][3]})
#define ISSUE_DMA(t_) do { if ((t_) + 3 < NT) DMA_K((t_) + 3, ks3); if ((t_) + 1 < NT) DMA_V((t_) + 1, vs1); } while (0)
#define PREFILL(t_) do { if ((t_) + 1 <= tmax) { const lds_cptr kn_ = kp0 + ks1; _Pragma("unroll") for (int i = 0; i < WD; ++i) { const bf16x8 kk_ = *(const LAS bf16x8*)(kn_ + (i / 2) * 2048 + (i % 2) * 512); flo[i] = (s16x4){kk_[0], kk_[1], kk_[2], kk_[3]}; fhi[i] = (s16x4){kk_[4], kk_[5], kk_[6], kk_[7]}; } } } while (0)
#define BIAS(t_) do { if constexpr (!MLA) { const int dmin_ = q0 + wid * 32 - 64 * (t_) - 63; \
        if (dmin_ < 559) { const LAS float* tb_ = (const LAS float*)(lds + C::LDS_BIAS) + (dmin_ + r32 + 126 - 4 * hi); \
            _Pragma("unroll") for (int r = 0; r < 16; ++r) { const int kk_ = (r & 3) + 8 * (r >> 2); c0[r] += tb_[-kk_]; c1[r] += tb_[-kk_ - 32]; } } } } while (0)
#define EXPW(w_) do { if ((w_) < 8) { c0[(2 * (w_)) & 15] = __builtin_amdgcn_exp2f(c0[(2 * (w_)) & 15]); c0[(2 * (w_) + 1) & 15] = __builtin_amdgcn_exp2f(c0[(2 * (w_) + 1) & 15]); } \
        else { c1[(2 * (w_)) & 15] = __builtin_amdgcn_exp2f(c1[(2 * (w_)) & 15]); c1[(2 * (w_) + 1) & 15] = __builtin_amdgcn_exp2f(c1[(2 * (w_) + 1) & 15]); } } while (0)
#define PACKW(PWN_, w_) do { const float a_ = CE(2 * (w_)), b_ = CE(2 * (w_) + 1); sacc_ += a_ + b_; PWN_[(w_) / 4][(w_) % 4] = cvtpk(a_, b_); } while (0)
#define STEP(t_, PWC_, PWN_) do { \
        const lds_cptr kp_ = kp0 + ks0, vp_ = vp0 + vsm; \
        __builtin_amdgcn_sched_barrier(0); \
        _Pragma("unroll") for (int g = 0; g < NQK; ++g) { const bf16x8 f_ = W_FRAG(g); \
            if ((g & 1) == 0) c0 = (g / 2 == 0) ? __builtin_amdgcn_mfma_f32_32x32x16_bf16(f_, qr[0], (f32x16){}, 0, 0, 0) : __builtin_amdgcn_mfma_f32_32x32x16_bf16(f_, qr[g / 2], c0, 0, 0, 0); \
            else c1 = (g / 2 == 0) ? __builtin_amdgcn_mfma_f32_32x32x16_bf16(f_, qr[0], (f32x16){}, 0, 0, 0) : __builtin_amdgcn_mfma_f32_32x32x16_bf16(f_, qr[g / 2], c1, 0, 0, 0); \
            if (g + WD < NOPS) W_LOAD(g + WD); \
            if (g == 1) { if ((t_) + 3 < NT) DMA_K((t_) + 3, ks3); } \
            if (g == 3) { if ((t_) + 1 < NT) DMA_V((t_) + 1, vs1); } \
            __builtin_amdgcn_sched_barrier(0); } \
        BIAS(t_); \
        __builtin_amdgcn_sched_barrier(0); \
        float sacc_ = 0.f; \
        _Pragma("unroll") for (int h = 0; h < NPV; ++h) { const bf16x8 f_ = W_FRAG(NQK + h); \
            o[h / 4] = __builtin_amdgcn_mfma_f32_32x32x16_bf16(__builtin_bit_cast(bf16x8, PWC_[h % 4]), f_, o[h / 4], 0, 0, 0); \
            if (NQK + h + WD < NOPS) W_LOAD(NQK + h + WD); \
            EXPW(h); if (h >= 1) PACKW(PWN_, h - 1); \
            asm volatile("" : "+v"(sacc_)); \
            __builtin_amdgcn_sched_barrier(0); } \
        PACKW(PWN_, 15); l_reg += sacc_; \
        PREFILL(t_); \
    } while (0)
#define DRAIN() do { f32x16 d0_ = f32x16{}, d1_ = f32x16{}; const f32x16 z_ = f32x16{}; mfma_slot<NKS, ND, true, false>(o, d0_, d1_, pwc, qr, z_, kp0 + ks0, vp0 + vsm); } while (0)
#define AT_CLOSE(t_) do { const int cnt_ = (((t_) + 3 < NT) ? C::NKD : 0) + (((t_) + 1 < NT) ? C::NVD : 0); \
        if (cnt_ == 3) { AT_WAITBAR_NL(3); } else if (cnt_ == 2) { AT_WAITBAR_NL(2); } else if (cnt_ == 1) { AT_WAITBAR_NL(1); } else { AT_WAITBAR_NL(0); } } while (0)
#define ROTATE() do { const int k_ = ks0; ks0 = ks1; ks1 = ks2; ks2 = ks3; ks3 = k_; const int v_ = vsm; vsm = vs0; vs0 = vs1; vs1 = v_; } while (0)
#define PW_ADVANCE() do { _Pragma("unroll") for (int k = 0; k < 4; ++k) pwc[k] = pwn[k]; } while (0)
    { ISSUE_DMA(0);
      const f32x16 z_ = f32x16{};
      mfma_slot<NKS, ND, false, true>(o, c0, c1, pwc, qr, z_, kp0 + ks0, vp0 + vsm);
      BIAS(0);
      float sacc_ = 0.f;
#pragma unroll
      for (int w = 0; w < 16; ++w) { EXPW(w); PACKW(pwc, w); }
      l_reg += sacc_;
      PREFILL(0);
      AT_CLOSE(0); ROTATE(); }
    int t = 1; const int tlast = tmax < NT - 1 ? tmax : NT - 1;
#pragma unroll 1
    for (; t + 1 <= tlast; t += 2) {
        STEP(t, pwc, pwn); AT_CLOSE(t); ROTATE();
        STEP(t + 1, pwn, pwc); AT_CLOSE(t + 1); ROTATE();
    }
    if (t <= tlast) { STEP(t, pwc, pwn); PW_ADVANCE(); AT_CLOSE(t); ROTATE(); ++t; }
    if (t < NT) { ISSUE_DMA(t); DRAIN(); AT_CLOSE(t); ROTATE(); ++t; }
#pragma unroll 1
    for (; t < NT; ++t) { ISSUE_DMA(t); AT_CLOSE(t); ROTATE(); }
    if (tmax == NT - 1) { DRAIN(); }
#undef CE
#undef W_LOAD
#undef W_FRAG
#undef ISSUE_DMA
#undef PREFILL
#undef BIAS
#undef EXPW
#undef PACKW
#undef STEP
#undef DRAIN
#undef ROTATE
#undef PW_ADVANCE
    { auto rr = __builtin_amdgcn_permlane32_swap(__float_as_uint(l_reg), __float_as_uint(l_reg), false, false); l_reg = __uint_as_float(rr[0]) + __uint_as_float(rr[1]); }
    if (hi == 0) wsf[32 + r32] = l_reg;
    asm volatile("s_waitcnt lgkmcnt(0)" ::: "memory");
    { int le = lane; asm volatile("" : "+v"(le));
      const int r32e = le & 31, hie = le >> 5;
      LAS bf16_t* stg = (LAS bf16_t*)(lds + C::LDS_OST + wid * C::OSTW);
      constexpr int RW = ND * 32;
#pragma unroll
      for (int r = 0; r < 16; ++r) { const int orow = (r & 3) + 8 * (r >> 2); const float rl = __builtin_amdgcn_rcpf(wsf[32 + 4 * hie + orow]);
#pragma unroll
          for (int d0 = 0; d0 < ND; ++d0) { const unsigned w = cvtpk(o[d0][r] * rl, 0.f); stg[(4 * hie + r32e) + orow * RW + d0 * 32 + (RW - 1) * 4 * hie] = (bf16_t)(w & 0xffffu); } }
      asm volatile("s_waitcnt lgkmcnt(0)" ::: "memory");
      constexpr int CPR = ND * 4, RPI = 64 / CPR;
      const int rowl = le / CPR, ch = le % CPR;
      const LAS bf16_t* sp = stg + rowl * RW + ch * 8;
      bf16_t* Ow = P.O + (size_t)(P.rowbase + q0 + wid * 32 + rowl) * P.ldo + ch * 8;
      if (MLA || P.O1 == nullptr) {
#pragma unroll
          for (int i = 0; i < ND * 2; ++i) { const u32x4 v = *(const LAS u32x4*)(sp + i * RPI * RW); *(u32x4*)(Ow + (size_t)(i * RPI) * P.ldo) = v; }
      } else {
          const float lam = *P.lamp; const f32x4 g0 = *(const f32x4*)(P.gout + ch * 8) * 0.8f, g1 = *(const f32x4*)(P.gout + ch * 8 + 4) * 0.8f;
          const bf16_t* O1p = P.O1 + (size_t)(P.rowbase + q0 + wid * 32 + rowl) * 1024 + ch * 8; bf16_t* Yp = P.Yc + (size_t)(P.rowbase + q0 + wid * 32 + rowl) * 1024 + ch * 8;
#pragma unroll
          for (int i = 0; i < ND * 2; ++i) { const u32x4 v2 = *(const LAS u32x4*)(sp + i * RPI * RW); const u32x4 v1 = *(const u32x4*)(O1p + (size_t)(i * RPI) * 1024);
              f32x4 a = (f32x4){bflo(v1.x) - lam * bflo(v2.x), bfhi(v1.x) - lam * bfhi(v2.x), bflo(v1.y) - lam * bflo(v2.y), bfhi(v1.y) - lam * bfhi(v2.y)};
              f32x4 b = (f32x4){bflo(v1.z) - lam * bflo(v2.z), bfhi(v1.z) - lam * bfhi(v2.z), bflo(v1.w) - lam * bflo(v2.w), bfhi(v1.w) - lam * bfhi(v2.w)};
              float ss = sq4(a) + sq4(b); ss += __shfl_xor(ss, 1); ss += __shfl_xor(ss, 2); ss += __shfl_xor(ss, 4); ss += __shfl_xor(ss, 8);
              const float r = rsqrtf(ss * (1.0f / 128.0f) + EPS);
              *(u32x4*)(Yp + (size_t)(i * RPI) * 1024) = pack8(a * g0 * r, b * g1 * r); }
      } }
    AT_BAR();
#undef DMA_K
#undef DMA_V
#undef AT_CLOSE
}
}

constexpr int NWAVES = 8;
#ifndef IW_MLA
#define IW_MLA 1
#endif
#ifndef IW_DIFF
#define IW_DIFF 1
#endif
constexpr int N_PHASES = 10;
#ifndef MK_N_LAUNCHES
#define MK_N_LAUNCHES 1
#endif
constexpr size_t MiB = 1u << 20;
constexpr size_t WS_CTL = 0, CTL_ZERO_BYTES = 64 * 1024;
constexpr size_t WS_WIN = 1 * MiB;
constexpr size_t WS_WUP = 5 * MiB;
constexpr size_t WS_WOUT = 7 * MiB;
constexpr size_t WS_WG = 9 * MiB;
constexpr size_t WS_WU = 15 * MiB;
constexpr size_t WS_WD = 21 * MiB;
constexpr size_t WS_WPG = 27 * MiB;
constexpr size_t WS_WPP = 29 * MiB;
constexpr size_t WS_ROPE = 30 * MiB;
constexpr size_t WS_BTAB = 31 * MiB;
constexpr size_t WS_SSQ = 32 * MiB;
constexpr size_t WS_SSKV = 33 * MiB;
constexpr size_t WS_KRSS = 34 * MiB;
constexpr size_t WS_KRR = 35 * MiB;
constexpr size_t WS_SS1 = 40 * MiB;
constexpr size_t WS_SS2 = 43 * MiB;
constexpr size_t WS_PB = 48 * MiB;
constexpr size_t WS_XN = 64 * MiB;
constexpr size_t WS_Z = 128 * MiB;
constexpr size_t WS_DKI = 192 * MiB;
constexpr size_t WS_DVI = 224 * MiB;
constexpr size_t WS_QR = 256 * MiB;
constexpr size_t WS_KM = 304 * MiB;
constexpr size_t WS_VM = 352 * MiB;
constexpr size_t WS_Y = 384 * MiB;
constexpr size_t WS_OD = 448 * MiB;
constexpr size_t WS_X1B = WS_XN;
constexpr size_t WS_G = 128 * MiB;
constexpr size_t WS_ACT = 304 * MiB;
constexpr size_t WS_X2B = 128 * MiB;
constexpr size_t WS_PR = 64 * MiB;
constexpr size_t WS_END = 512 * MiB;
constexpr int CW_BAR = 1024;
constexpr int RING_BYTES = 131072, LDS_BYTES = 155648, MISC_OFF = LDS_BYTES - 256;
static_assert(attn::Cfg<4, 4, 4>::LDS_END <= MISC_OFF && attn::Cfg<6, 2, 4>::LDS_END <= MISC_OFF && MISC_OFF + 256 <= 160 * 1024, "attention LDS map");

typedef GAS unsigned gu32;
#define VM_WAIT() asm volatile("s_waitcnt vmcnt(0)" ::: "memory")
#define LDS_WAIT() asm volatile("s_waitcnt lgkmcnt(0)" ::: "memory")

#define XB_TMO      128
#define XB_XCNT(j)  (256  + 64 * (j))
#define XB_XSUB(j)  (1280 + 64 * (j))
#define XB_XGEN(j)  (2304 + 64 * (j))
#define XB_TOP      3328
#define XB_TOPGEN   3392
#define XCD_BAR_WORDS 3456
#define XB_SPIN_CAP (1u << 18)
__device__ __forceinline__ unsigned xb_ld(unsigned* p)              { return __hip_atomic_load(p, __ATOMIC_RELAXED, __HIP_MEMORY_SCOPE_AGENT); }
__device__ __forceinline__ unsigned xb_add(unsigned* p, unsigned v) { return __hip_atomic_fetch_add(p, v, __ATOMIC_RELAXED, __HIP_MEMORY_SCOPE_AGENT); }
__device__ __forceinline__ unsigned xb_xcc_id() { return (unsigned)__builtin_amdgcn_s_getreg((3 << 11) | 20) & 0xFu; }
#define XB_SPIN(cond, bar) do { unsigned _sp = 0; while (cond) { __builtin_amdgcn_s_sleep(1); \
    if ((++_sp & 255u) == 0u) { if (xb_ld(&(bar)[XB_TMO])) break; if (_sp > XB_SPIN_CAP) { atomicAdd(&(bar)[XB_TMO], 1u); break; } } } } while (0)
struct XcdBarrier { unsigned* bar; unsigned x; volatile LAS unsigned* st; };
__device__ __forceinline__ XcdBarrier xcd_barrier_post(unsigned* bar, volatile LAS unsigned* st) {
    XcdBarrier b; b.bar = bar; b.x = xb_xcc_id(); b.st = st;
    if (threadIdx.x == 0) (void)xb_add(&bar[XB_XCNT(b.x)], 1u);
    return b;
}
__device__ __forceinline__ void xcd_barrier_complete(unsigned* bar, unsigned x, unsigned& nloc, unsigned& nx) {
    const unsigned G = gridDim.x * gridDim.y * gridDim.z;
    unsigned sum, cnt, mine, sp = 0u;
    for (;;) {
        sum = 0u; cnt = 0u; mine = 0u;
#pragma unroll
        for (unsigned j = 0; j < 16; ++j) { const unsigned c = xb_ld(&bar[XB_XCNT(j)]); sum += c; cnt += (c > 0u) ? 1u : 0u; mine = (j == x) ? c : mine; }
        if (sum == G) break;
        __builtin_amdgcn_s_sleep(1);
        if ((++sp & 255u) == 0u) { if (xb_ld(&bar[XB_TMO])) break; if (sp > XB_SPIN_CAP) { atomicAdd(&bar[XB_TMO], 1u); break; } }
    }
    nloc = mine > 0u ? mine : 1u; nx = cnt > 0u ? cnt : 1u;
}
__device__ __forceinline__ void xcd_barrier(const XcdBarrier& b) {
    asm volatile("s_waitcnt vmcnt(0)" ::: "memory");
    __syncthreads();
    if (threadIdx.x == 0) {
        unsigned* bar = b.bar;
        __builtin_amdgcn_s_waitcnt(0);
        unsigned nloc = b.st[0], nx = b.st[1];
        if (nloc == 0u) { xcd_barrier_complete(bar, b.x, nloc, nx); b.st[0] = nloc; b.st[1] = nx; }
        const unsigned old = xb_add(&bar[XB_XSUB(b.x)], 1u);
        const unsigned gen = old / nloc;
        if (old + 1u == (gen + 1u) * nloc) {
            __builtin_amdgcn_fence(__ATOMIC_RELEASE, "agent");
            asm volatile("s_waitcnt vmcnt(0)" ::: "memory");
            const unsigned og = xb_add(&bar[XB_TOP], 1u);
            const unsigned tg = og / nx;
            if (og + 1u == (tg + 1u) * nx) xb_add(&bar[XB_TOPGEN], 1u);
            else XB_SPIN(xb_ld(&bar[XB_TOPGEN]) == tg, bar);
            __builtin_amdgcn_fence(__ATOMIC_ACQUIRE, "agent");
            xb_add(&bar[XB_XGEN(b.x)], 1u);
            asm volatile("s_waitcnt vmcnt(0)" ::: "memory");
        } else {
            XB_SPIN(xb_ld(&bar[XB_XGEN(b.x)]) == gen, bar);
            __builtin_amdgcn_fence(__ATOMIC_ACQUIRE, "agent");
            asm volatile("s_waitcnt vmcnt(0)" ::: "memory");
        }
    }
    __syncthreads();
}

struct Args { const float* in[28]; float* out; unsigned char* ws; int ph_lo, ph_hi; };

__device__ __forceinline__ float wave_sum(float v) {
#pragma unroll
    for (int o = 1; o < 64; o <<= 1) v += __shfl_xor(v, o);
    return v;
}
__device__ __forceinline__ int t5_bucket(int rel) {
    const int nb = 16, max_exact = 8;
    const int sign_off = rel > 0 ? nb : 0;
    const int n = rel < 0 ? -rel : rel;
    const float nf = (float)(n > 1 ? n : 1);
    int large = max_exact + (int)(logf(nf / 8.0f) / 4.852030263919617f * 8.0f);
    large = large < nb - 1 ? large : nb - 1;
    return sign_off + (n < max_exact ? n : large);
}

__device__ __forceinline__ void wt_item(const float* W, int ldw, int srccol0, int srck0, const float* gain, bf16_t* WT, int ldk, int dstrow0, int dstk0, LAS float* scr, int lane) {
    const int c = lane & 7;
    if (W == nullptr) {
#pragma unroll
        for (int j = 0; j < 4; ++j) { const int n = (lane >> 3) + 8 * j; *(GAS u32x4*)(WT + (size_t)(dstrow0 + n) * ldk + dstk0 + 8 * c) = (u32x4){0u, 0u, 0u, 0u}; }
        return;
    }
    float wv[32];
#pragma unroll
    for (int i = 0; i < 32; ++i) { const int kk = 2 * i + (lane >> 5); wv[i] = W[(size_t)(srck0 + kk) * ldw + srccol0 + (lane & 31)]; }
    if (gain) {
#pragma unroll
        for (int i = 0; i < 32; ++i) wv[i] *= gain[srck0 + 2 * i + (lane >> 5)];
    }
#pragma unroll
    for (int i = 0; i < 32; ++i) scr[(2 * i + (lane >> 5)) * 33 + (lane & 31)] = wv[i];
    LDS_WAIT(); asm volatile("" ::: "memory");
#pragma unroll
    for (int j = 0; j < 4; ++j) { const int n = (lane >> 3) + 8 * j; const LAS float* s = scr + (8 * c) * 33 + n;
        u32x4 o; o.x = cvtpk(s[0 * 33], s[1 * 33]); o.y = cvtpk(s[2 * 33], s[3 * 33]); o.z = cvtpk(s[4 * 33], s[5 * 33]); o.w = cvtpk(s[6 * 33], s[7 * 33]);
        *(GAS u32x4*)(WT + (size_t)(dstrow0 + n) * ldk + dstk0 + 8 * c) = o; }
    LDS_WAIT(); asm volatile("" ::: "memory");
}

__device__ __forceinline__ int win_src_col(int b32) {
    const int pn = b32 >> 3, q = b32 & 7, bj = q >> 2, wc = q & 3;
    if (pn == 0) return OFF_Q_LAT + 32 * q;
    if (pn == 1) return bj == 0 ? OFF_KV_LAT + 32 * wc : (wc == 0 ? OFF_K_ROPE : -1);
    if (pn < 4) return OFF_DIFF_Q + 64 * (4 * (pn - 2) + wc) + 32 * bj;
    if (pn < 6) return OFF_DIFF_K + 64 * (4 * (pn - 4) + wc) + 32 * bj;
    return OFF_DIFF_V + 256 * (pn - 6) + 32 * q;
}


typedef const __attribute__((address_space(4))) Args* KArgs;
#define PHASE_PTRS() \
    KArgs ap = (KArgs)__builtin_amdgcn_kernarg_segment_ptr(); asm volatile("" : "+s"(ap)); \
    unsigned char* const ws = ap->ws; float* const out = ap->out; (void)out; \
    const float* const x = ap->in[0]; const float* const p_in = ap->in[1]; const float* const attn_norm_g = ap->in[2]; const float* const w_in = ap->in[3]; \
    const float* const q_lat_norm_g = ap->in[4]; const float* const w_uq = ap->in[5]; const float* const kv_lat_norm_g = ap->in[6]; const float* const w_ukv = ap->in[7]; \
    const float* const mla_q_norm_g = ap->in[8]; const float* const mla_k_norm_g = ap->in[9]; const float* const diff_q_norm_g = ap->in[10]; const float* const diff_k_norm_g = ap->in[11]; \
    const float* const lq1 = ap->in[12]; const float* const lk1 = ap->in[13]; const float* const lq2 = ap->in[14]; const float* const lk2 = ap->in[15]; \
    const float* const diff_out_norm_g = ap->in[16]; const float* const rel_bias = ap->in[17]; const float* const w_out = ap->in[18]; const float* const ffn_norm_g = ap->in[19]; \
    const float* const w_gate = ap->in[20]; const float* const w_up = ap->in[21]; const float* const conv_w = ap->in[22]; const float* const conv_b = ap->in[23]; const float* const w_down = ap->in[24]; \
    const float* const ple_norm_g = ap->in[25]; const float* const w_ple_gate = ap->in[26]; const float* const w_ple_proj = ap->in[27]; \
    bf16_t* const WIN = (bf16_t*)(ws + WS_WIN); bf16_t* const WUP = (bf16_t*)(ws + WS_WUP); bf16_t* const WUKV = (bf16_t*)(ws + WS_WUP + 512 * 1024); bf16_t* const WOUT = (bf16_t*)(ws + WS_WOUT); bf16_t* const WG = (bf16_t*)(ws + WS_WG); \
    bf16_t* const WU = (bf16_t*)(ws + WS_WU); bf16_t* const WD = (bf16_t*)(ws + WS_WD); bf16_t* const WPG = (bf16_t*)(ws + WS_WPG); bf16_t* const WPP = (bf16_t*)(ws + WS_WPP); \
    float* const ROPE = (float*)(ws + WS_ROPE); float* const BTAB = (float*)(ws + WS_BTAB); \
    float* const SSQ = (float*)(ws + WS_SSQ); float* const SSKV = (float*)(ws + WS_SSKV); float* const KRSS = (float*)(ws + WS_KRSS); float* const KRR = (float*)(ws + WS_KRR); \
    float* const SS1 = (float*)(ws + WS_SS1); float* const SS2 = (float*)(ws + WS_SS2); \
    bf16_t* const PB = (bf16_t*)(ws + WS_PB); bf16_t* const XN = (bf16_t*)(ws + WS_XN); bf16_t* const Z = (bf16_t*)(ws + WS_Z); bf16_t* const QR = (bf16_t*)(ws + WS_QR); \
    bf16_t* const KM = (bf16_t*)(ws + WS_KM); bf16_t* const VM = (bf16_t*)(ws + WS_VM); bf16_t* const DKI = (bf16_t*)(ws + WS_DKI); bf16_t* const DVI = (bf16_t*)(ws + WS_DVI); bf16_t* const Y = (bf16_t*)(ws + WS_Y); bf16_t* const OD = (bf16_t*)(ws + WS_OD); \
    bf16_t* const X1B = (bf16_t*)out; bf16_t* const GT = (bf16_t*)(ws + WS_G); bf16_t* const ACT = (bf16_t*)(ws + WS_ACT); bf16_t* const X2B = (bf16_t*)(ws + WS_X2B); bf16_t* const PRB = (bf16_t*)(ws + WS_PR); \
    (void)x; (void)p_in; (void)attn_norm_g; (void)w_in; (void)q_lat_norm_g; (void)w_uq; (void)kv_lat_norm_g; (void)w_ukv; (void)mla_q_norm_g; (void)mla_k_norm_g; (void)diff_q_norm_g; (void)diff_k_norm_g; \
    (void)lq1; (void)lk1; (void)lq2; (void)lk2; (void)diff_out_norm_g; (void)rel_bias; (void)w_out; (void)ffn_norm_g; (void)w_gate; (void)w_up; (void)conv_w; (void)conv_b; (void)w_down; (void)ple_norm_g; (void)w_ple_gate; (void)w_ple_proj; \
    (void)WIN; (void)WUP; (void)WUKV; (void)WOUT; (void)WG; (void)WU; (void)WD; (void)WPG; (void)WPP; (void)ROPE; (void)BTAB; (void)SSQ; (void)SSKV; (void)KRSS; (void)KRR; (void)SS1; (void)SS2; (void)PB; (void)XN; (void)Z; (void)QR; (void)KM; (void)VM; (void)DKI; (void)DVI; (void)Y; (void)OD; (void)X1B; (void)GT; (void)ACT; (void)X2B; (void)PRB

__global__ void __launch_bounds__(NWAVES * 64, 2) mk_fwd(Args args) {
    extern __shared__ __attribute__((aligned(16))) unsigned char lds_raw[];
    LAS unsigned char* lds = (LAS unsigned char*)lds_raw;
    volatile LAS unsigned* MISC = (volatile LAS unsigned*)(lds + MISC_OFF);
    const int tid = threadIdx.x, lane = tid & 63, wave = __builtin_amdgcn_readfirstlane(tid >> 6);
    const int G = gridDim.x, bx = blockIdx.x;
    const int vcu = (G % 8 == 0) ? (bx % 8) * (G / 8) + bx / 8 : bx;
    gu32* ctl = (gu32*)(args.ws + WS_CTL);
    if (tid < 64) MISC[tid] = 0u;
    __syncthreads();
    XcdBarrier bar = xcd_barrier_post((unsigned*)ctl + CW_BAR, MISC + 8);
    const int lo = args.ph_lo, hi_ph = args.ph_hi;
#ifndef PH_MASK
#define PH_MASK 0x3ff
#endif
#define IN(k) (((PH_MASK >> (k)) & 1) && lo <= (k) && (k) < hi_ph)
#define BOTH(k) (IN(k) && IN((k) + 1))
#ifndef REP_MASK
#define REP_MASK 0
#endif
#define NREP(k) (1 + ((REP_MASK >> (k)) & 1))
#define GRID_BAR() xcd_barrier(bar)
    const int gw = vcu * NWAVES + wave, NGW = G * NWAVES;

    if (IN(0)) {
        PHASE_PTRS();
        LAS float* scr = (LAS float*)(lds + wave * 16384);
        constexpr int I_IN = 64 * 16, I_UQ = 24 * 4, I_UKV = 32 * 2, I_OUT = 32 * 16, I_G = 88 * 16, I_U = 88 * 16, I_D = 32 * 44, I_PG = 32 * 16, I_PP = 32 * 4;
        constexpr int NITEMS = I_IN + I_UQ + I_UKV + I_OUT + I_G + I_U + I_PP;
        (void)I_D; (void)I_PG;
        for (int it = gw; it < NITEMS; it += NGW) {
            int r = it;
            if (r < I_IN) { const int nb = r / 16, kb = r % 16; const int sc = win_src_col(nb);
                wt_item(sc < 0 ? nullptr : w_in, IN_COLS, sc, 64 * kb, attn_norm_g, WIN, 1024, 32 * nb, 64 * kb, scr, lane); continue; } r -= I_IN;
            if (r < I_UQ) { wt_item(w_uq, 768, 32 * (r / 4), 64 * (r % 4), q_lat_norm_g, WUP, 256, 32 * (r / 4), 64 * (r % 4), scr, lane); continue; } r -= I_UQ;
            if (r < I_UKV) { const int nb = r / 2, kb = r % 2; const int pn = nb >> 3, q = nb & 7, bj = q >> 2, wc = q & 3;
                int sc; if (pn < 2) sc = 128 * (4 * pn + wc) + 32 * bj; else { const int p0 = 256 * (pn - 2) + 32 * q; sc = 128 * (p0 / 64) + 64 + (p0 % 64); }
                wt_item(w_ukv, 1024, sc, 64 * kb, kv_lat_norm_g, WUKV, 128, 32 * nb, 64 * kb, scr, lane); continue; } r -= I_UKV;
            if (r < I_OUT) { wt_item(w_out, 1024, 32 * (r / 16), 64 * (r % 16), nullptr, WOUT, 1024, 32 * (r / 16), 64 * (r % 16), scr, lane); continue; } r -= I_OUT;
            if (r < I_G) { wt_item(w_gate, D_FF, 32 * (r / 16), 64 * (r % 16), ffn_norm_g, WG, 1024, 32 * (r / 16), 64 * (r % 16), scr, lane); continue; } r -= I_G;
            if (r < I_U) { wt_item(w_up, D_FF, 32 * (r / 16), 64 * (r % 16), ffn_norm_g, WU, 1024, 32 * (r / 16), 64 * (r % 16), scr, lane); continue; } r -= I_U;
            wt_item(w_ple_proj, 1024, 32 * (r / 4), 64 * (r % 4), nullptr, WPP, 256, 32 * (r / 4), 64 * (r % 4), scr, lane);
        }
        for (int m0 = gw * 4; m0 < T_TOK; m0 += NGW * 4) {
            f32x4 v[4][4]; float s[4];
#pragma unroll
            for (int q = 0; q < 4; ++q) { const GAS f32x4* xr = (const GAS f32x4*)(x + (size_t)(m0 + q) * D_MODEL) + lane;
#pragma unroll
                for (int j = 0; j < 4; ++j) v[q][j] = xr[64 * j]; }
#pragma unroll
            for (int q = 0; q < 4; ++q) { s[q] = 0.f;
#pragma unroll
                for (int j = 0; j < 4; ++j) s[q] += sq4(v[q][j]); }
#pragma unroll
            for (int q = 0; q < 4; ++q) { const float r = rsqrtf(wave_sum(s[q]) * (1.0f / D_MODEL) + EPS);
                GAS u32x2* o8 = (GAS u32x2*)(XN + (size_t)(m0 + q) * D_MODEL) + lane;
#pragma unroll
                for (int j = 0; j < 4; ++j) o8[64 * j] = (u32x2){cvtpk(v[q][j][0] * r, v[q][j][1] * r), cvtpk(v[q][j][2] * r, v[q][j][3] * r)}; }
        }
        { const size_t n8 = ((T_TOK / 256) * (D_FF / 256) % G == 0) ? (size_t)T_TOK * PLE_DIM / 8 : 0;
          const size_t gt = (size_t)vcu * (NWAVES * 64) + tid, NGT = (size_t)G * NWAVES * 64;
          for (size_t i = gt; i < n8; i += 4 * NGT) { f32x4 a[4], b[4];
#pragma unroll
              for (int q = 0; q < 4; ++q) { const size_t ii = i + q * NGT; if (ii < n8) { a[q] = *(const GAS f32x4*)(p_in + ii * 8); b[q] = *(const GAS f32x4*)(p_in + ii * 8 + 4); } }
#pragma unroll
              for (int q = 0; q < 4; ++q) { const size_t ii = i + q * NGT; if (ii < n8) *(GAS u32x4*)(PB + ii * 8) = pack8(a[q], b[q]); } }
          for (size_t i = gt; i < (size_t)SEQ * 16; i += NGT) { const int pos = (int)(i >> 4), k = (int)(i & 15); const float inv = powf(10000.0f, -(float)k / 16.0f); const float ang = (float)pos * inv;
              ROPE[(size_t)pos * 32 + k] = cosf(ang); ROPE[(size_t)pos * 32 + 16 + k] = sinf(ang); }
          for (size_t i = gt; i < 4096; i += NGT) { const int h = (int)(i >> 10), k = (int)(i & 1023); BTAB[i] = (rel_bias[t5_bucket(63 - k) * 4 + h] - rel_bias[15 * 4 + h]) * LOG2E; }
          if (gw == 0) {
              const float s1 = wave_sum(lq1[lane] * lk1[lane]), s2 = wave_sum(lq2[lane] * lk2[lane]);
              float mq = fmaxf(fabsf(mla_q_norm_g[lane]), lane < 32 ? fabsf(mla_q_norm_g[64 + lane]) : 0.f), mk = fmaxf(fabsf(mla_k_norm_g[lane]), lane < 32 ? fabsf(mla_k_norm_g[64 + lane]) : 0.f);
              float dq = fabsf(diff_q_norm_g[lane]), dk = fabsf(diff_k_norm_g[lane]), mb = fmaxf(fabsf(rel_bias[lane]), fabsf(rel_bias[64 + lane]));
#pragma unroll
              for (int o = 1; o < 64; o <<= 1) { mq = fmaxf(mq, __shfl_xor(mq, o)); mk = fmaxf(mk, __shfl_xor(mk, o)); dq = fmaxf(dq, __shfl_xor(dq, o)); dk = fmaxf(dk, __shfl_xor(dk, o)); mb = fmaxf(mb, __shfl_xor(mb, o)); }
              if (lane == 0) { BTAB[4096] = expf(s1) - expf(s2) + 0.2f;
                  BTAB[4097] = 96.0f * mq * mk * 0.10206207261596577f * LOG2E;
                  BTAB[4098] = 64.0f * dq * dk * 0.125f * LOG2E + 2.0f * mb * LOG2E; } }
        }
        if (BOTH(0)) GRID_BAR();
    }
    if (IN(1)) for (int rep_ = 0; rep_ < NREP(1); ++rep_) {
        PHASE_PTRS();
        pg8::Gemm g{XN, WIN, T_TOK, 2048, 1024, 1024}; pg8::StaticOrder S; S.init(T_TOK, 2048, G, bx);
        EpiIn E{lds + RING_BYTES, Z, DKI, DVI, SSQ, SSKV, KRR, KRSS, ROPE, diff_q_norm_g, diff_k_norm_g, mla_k_norm_g};
        pg8::gemm_phase(lds, g, S, E);
        if (BOTH(1)) GRID_BAR();
    }
    if (IN(2)) for (int rep_ = 0; rep_ < NREP(2); ++rep_) {
        PHASE_PTRS();
        int kq = 256, kkv = 128; asm volatile("" : "+s"(kq), "+s"(kkv));
        const int hq = G / 2;
        if (bx < hq) { pg8::Gemm g{Z, WUP, T_TOK, 768, kq, ZLD}; IdleOrder S{0, bx, hq, (T_TOK / 256) * 3, 3};
          EpiUp<false> E{lds + RING_BYTES, QR, KM, VM, SSQ, SSKV, KRR, KRSS, mla_k_norm_g}; pg8::gemm_phase(lds, g, S, E); }
        else { pg8::Gemm g{Z + 256, WUKV, T_TOK, 1024, kkv, ZLD}; IdleOrder S{0, bx - hq, G - hq, (T_TOK / 256) * 4, 4};
          EpiUp<true> E{lds + RING_BYTES, QR, KM, VM, SSQ, SSKV, KRR, KRSS, mla_k_norm_g}; pg8::gemm_phase(lds, g, S, E); }
        if (BOTH(2)) GRID_BAR();
    }
    if (IN(3)) {
        PHASE_PTRS();
        const bool att_fixed_mla = BTAB[4097] >= 0.f && BTAB[4097] < 64.0f, att_fixed_diff = BTAB[4098] >= 0.f && BTAB[4098] < 64.0f;
        if (vcu < 256) { const int vu = vcu;
        const int s = vu & 7, bh = vu >> 3;
        for (int i_ = 0; i_ < 4 * NREP(3); ++i_) { const int i = i_ & 3; const int qb = (i == 0) ? s : (i == 1) ? 15 - s : (i == 2) ? 16 + s : 31 - s;
            const int b = bh >> 3, h = bh & 7;
            attn::UnitP P{QR + 96 * h, 768, KM + kimg(12, b * 8 + h, 0, 0, 0), 0, VM + vimg(2, b * 8 + h, 0, 0, 0, 0, 0), 0, Y + 64 * h, 1024, qb, (long)b * SEQ, nullptr, BTAB + 4097, nullptr, nullptr, nullptr, nullptr};
#ifndef NO_MLA
            if (IW_MLA && att_fixed_mla) attn::attn_unit_iw<6, 2, true>(P, lds, ROPE, mla_q_norm_g); else attn::attn_unit<6, 2, true>(P, lds, ROPE, mla_q_norm_g);
#endif
            }
        for (int i_ = 0; i_ < 4 * NREP(4); ++i_) { const int i = i_ & 3; const int half = bh & 1, h = (bh >> 1) & 3, b = bh >> 3, m = i & 1;
            const int qb = (half == 0) ? ((i < 2) ? s : 31 - s) : ((i < 2) ? 8 + s : 23 - s); const int hm = 2 * h + m;
            attn::UnitP P{Z + Z_DQ + 64 * hm, ZLD, DKI + kimg(8, b * 8 + hm, 0, 0, 0), 0, DVI + vimg(4, b * 4 + h, 0, 0, 0, 0, 0), 0, OD + 128 * hm, 1024, qb, (long)b * SEQ, BTAB + 1024 * h, BTAB + 4098,
                          m ? OD + 128 * (2 * h) : nullptr, Y + 512 + 128 * h, diff_out_norm_g, BTAB + 4096};
#ifndef NO_DIFF
            if (IW_DIFF && att_fixed_diff) attn::attn_unit_iw2<4, 4, false>(P, lds, nullptr, nullptr); else attn::attn_unit<4, 4, false>(P, lds, nullptr, nullptr);
#endif
            }
        }
        if (BOTH(3)) GRID_BAR();
    }
    if (IN(5)) for (int rep_ = 0; rep_ < NREP(5); ++rep_) {
        PHASE_PTRS();
        pg8::Gemm g{Y, WOUT, T_TOK, 1024, 1024, 1024}; pg8::StaticOrder S; S.init(T_TOK, 1024, G, bx);
        EpiRes<false> E{x, X1B, SS1};
        pg8::gemm_phase(lds, g, S, E);
        if (BOTH(5)) GRID_BAR();
    }
    if (IN(6)) for (int rep_ = 0; rep_ < NREP(6); ++rep_) {
        PHASE_PTRS();
        pg8::Gemm g{X1B, WG, T_TOK, D_FF, 1024, 1024}; pg8::StaticOrder S; S.init(T_TOK, D_FF, G, bx);
        EpiGate E{GT, SS1};
        pg8::gemm_phase(lds, g, S, E);
        { const int nbusy = (T_TOK / 256) * (D_FF / 256) % G;
          if (nbusy > 0 && bx >= nbusy) { const int ic = bx - nbusy, per = (256 + (G - nbusy) - 1) / (G - nbusy);
              const int u0 = per * ic, u1 = (u0 + per < 256 ? u0 + per : 256);
              if (u0 < 256) { const int r0 = (u0 >> 2) * 256, r1 = ((u1 - 1) >> 2) * 256 + 256; convert_p_rows(p_in, PB, r0, r1 - r0, tid); }
              pg8::Gemm g2{PB, WPP, T_TOK, 1024, 256, 256}; PanelOrder S2{0, ic, per, 256}; EpiBf E2{PRB}; pg8::gemm_phase(lds, g2, S2, E2); } }
        if (BOTH(6)) GRID_BAR();
    }
    if (IN(7)) for (int rep_ = 0; rep_ < NREP(7); ++rep_) {
        PHASE_PTRS();
        pg8::Gemm g{X1B, WU, T_TOK, D_FF, 1024, 1024}; pg8::StaticOrder S; S.init(T_TOK, D_FF, G, bx);
        EpiUpAct E{GT, ACT, SS1, conv_w, conv_b};
        pg8::gemm_phase(lds, g, S, E);
        { const int nbusy = (T_TOK / 256) * (D_FF / 256) % G;
          if (nbusy > 0 && bx >= nbusy) { const int ic = bx - nbusy, per = (256 + (G - nbusy) - 1) / (G - nbusy);
              const int u0 = per * ic, u1 = (u0 + per < 256 ? u0 + per : 256);
              if (u0 < 256) { const int r0 = ((256 + u0) >> 2) * 256, r1 = ((256 + u1 - 1) >> 2) * 256 + 256; convert_p_rows(p_in, PB, r0, r1 - r0, tid); }
              pg8::Gemm g2{PB, WPP, T_TOK, 1024, 256, 256}; PanelOrder S2{256, ic, per, 256}; EpiBf E2{PRB}; pg8::gemm_phase(lds, g2, S2, E2); }
          else if (nbusy == 0) { pg8::Gemm g2{PB, WPP, T_TOK, 1024, 256, 256}; pg8::StaticOrder S2; S2.init(T_TOK, 1024, G, bx); EpiBf E2{PRB}; pg8::gemm_phase(lds, g2, S2, E2); }
          {
            constexpr int J_D = 32 * 44, J_PG = 32 * 16; LAS float* scr = (LAS float*)(lds + wave * 16384);
            const int w0 = nbusy > 0 ? (bx - nbusy) * NWAVES + wave : bx * NWAVES + wave, nw = (nbusy > 0 ? (G - nbusy) : G) * NWAVES;
            if (nbusy == 0 || bx >= nbusy)
                for (int it = w0; it < J_D + J_PG; it += nw) {
                    if (it < J_D) wt_item(w_down, 1024, 32 * (it / 44), 64 * (it % 44), nullptr, WD, D_FF, 32 * (it / 44), 64 * (it % 44), scr, lane);
                    else { const int r = it - J_D; wt_item(w_ple_gate, 1024, 32 * (r / 16), 64 * (r % 16), ple_norm_g, WPG, 1024, 32 * (r / 16), 64 * (r % 16), scr, lane); } } }
        }
        if (BOTH(7)) GRID_BAR();
    }
    if (IN(8)) {
        PHASE_PTRS();
        pg8::Gemm g{ACT, WD, T_TOK, 1024, D_FF, D_FF}; pg8::StaticOrder S; S.init(T_TOK, 1024, G, bx);
        EpiRes<true> E{X1B, X2B, SS2};
        pg8::gemm_phase(lds, g, S, E);
        if (BOTH(8)) GRID_BAR();
    }
    if (IN(9)) {
        PHASE_PTRS();
        { pg8::Gemm g{X2B, WPG, T_TOK, 1024, 1024, 1024}; pg8::StaticOrder S; S.init(T_TOK, 1024, G, bx); EpiPle E{out, X2B, PRB, SS2}; pg8::gemm_phase(lds, g, S, E); }
    }
#undef IN
#undef BOTH
#undef GRID_BAR
}

extern "C" void kernel_launch(void* const* d_in, const int* in_sizes, int n_in, void* d_out, int out_size, void* d_ws, size_t ws_size, hipStream_t stream) {
    static int grid = 0;
    if (grid == 0) {
        if (n_in != 28 || out_size != T_TOK * D_MODEL || ws_size < WS_END) { fprintf(stderr, "kernel_launch: unexpected shapes (n_in %d out %d ws %zu)\n", n_in, out_size, ws_size); grid = -1; return; }
        int dev = 0, cus = 0, per_cu = 0;
        if (hipGetDevice(&dev) != hipSuccess || hipDeviceGetAttribute(&cus, hipDeviceAttributeMultiprocessorCount, dev) != hipSuccess) { grid = -1; return; }
        if (hipFuncSetAttribute((const void*)mk_fwd, hipFuncAttributeMaxDynamicSharedMemorySize, LDS_BYTES) != hipSuccess) { fprintf(stderr, "kernel_launch: hipFuncSetAttribute failed\n"); grid = -1; return; }
        if (hipOccupancyMaxActiveBlocksPerMultiprocessor(&per_cu, (const void*)mk_fwd, NWAVES * 64, LDS_BYTES) != hipSuccess || per_cu < 1) { fprintf(stderr, "kernel_launch: occupancy query says %d blocks per CU\n", per_cu); }
        (void)hipGetLastError();
        grid = cus;
    }
    if (grid < 0) return;
    (void)hipMemsetAsync((char*)d_ws + WS_CTL, 0, CTL_ZERO_BYTES, stream);
    Args a{};
    for (int i = 0; i < 28; ++i) a.in[i] = (const float*)d_in[i];
    a.out = (float*)d_out; a.ws = (unsigned char*)d_ws;
#if MK_N_LAUNCHES == 1
    a.ph_lo = 0; a.ph_hi = N_PHASES;
    void* kargs[] = {&a};
    hipError_t e = hipLaunchCooperativeKernel((const void*)mk_fwd, dim3(grid), dim3(NWAVES * 64), kargs, LDS_BYTES, stream);
    if (e != hipSuccess) fprintf(stderr, "kernel_launch: cooperative launch failed: %s (grid %d)\n", hipGetErrorString(e), grid);
#else
    for (int ph = 0; ph < N_PHASES; ++ph) { a.ph_lo = ph; a.ph_hi = ph + 1; hipLaunchKernelGGL(mk_fwd, dim3(grid), dim3(NWAVES * 64), LDS_BYTES, stream, a); }
#endif
}
```

```cpp
#include <hip/hip_runtime.h>
#include <cstdio>
#include <cstdint>
#include <cmath>

#define LAS __attribute__((address_space(3)))
#define GAS __attribute__((address_space(1)))
typedef unsigned short bf16_t;
typedef short bf16x8 __attribute__((ext_vector_type(8)));
typedef short s16x4 __attribute__((ext_vector_type(4)));
typedef float f32x2 __attribute__((ext_vector_type(2)));
typedef float f32x4 __attribute__((ext_vector_type(4)));
typedef float f32x16 __attribute__((ext_vector_type(16)));
typedef unsigned u32x2 __attribute__((ext_vector_type(2)));
typedef unsigned u32x4 __attribute__((ext_vector_type(4)));
typedef __bf16 bf16x2_t __attribute__((ext_vector_type(2)));

constexpr int D_MODEL = 1024, BATCH = 4, SEQ = 8192, PLE_DIM = 256, T_TOK = BATCH * SEQ;
constexpr int D_FF = 2816;
constexpr int OFF_Q_LAT = 0, OFF_KV_LAT = 256, OFF_K_ROPE = 384, OFF_DIFF_Q = 416, OFF_DIFF_K = 928, OFF_DIFF_V = 1440, IN_COLS = 1952;
constexpr float EPS = 1e-6f;
constexpr float LOG2E = 1.4426950408889634f;
constexpr int ZLD = 1024;
constexpr int Z_DQ = 512;
__host__ __device__ __forceinline__ size_t kimg(int nch, int bh, int t, int c, int r) { return ((((size_t)bh * (SEQ / 64) + t) * nch + c) * 64 + r) * 8; }
__host__ __device__ __forceinline__ size_t vimg(int nd, int bh, int t, int d0, int ks, int r16, int col) { return ((((size_t)bh * (SEQ / 64) + t) * nd + d0) * 4 + ks) * 512 + r16 * 32 + col; }

__device__ __forceinline__ unsigned cvtpk(float lo, float hi) { f32x2 v = {lo, hi}; bf16x2_t b = __builtin_convertvector(v, bf16x2_t); return __builtin_bit_cast(unsigned, b); }
__device__ __forceinline__ float bf2f(short h) { return __uint_as_float(((unsigned)(unsigned short)h) << 16); }
__device__ __forceinline__ float bflo(unsigned w) { return __uint_as_float(w << 16); }
__device__ __forceinline__ float bfhi(unsigned w) { return __uint_as_float(w & 0xffff0000u); }

namespace pg8 {
constexpr int BM = 256, BK = 64, HALF = 128, HTB = HALF * BK * 2, STAGE_BYTES = 8 * HTB, NXCD = 8, WGM = 8;
__host__ __device__ __forceinline__ int lds_byte(int r, int c) { const int st = (r >> 4) * 2 + (c >> 5), rr = r & 15, cc = c & 31, ob = rr * 64 + cc * 2; return st * 1024 + (ob ^ (((ob >> 9) & 1) << 5)); }
__host__ __device__ __forceinline__ void stage_rc(int b, int& R, int& C) { const int st = b / 1024, sb = b % 1024, swz = sb ^ (((sb >> 9) & 1) << 5); R = (st >> 1) * 16 + swz / 64; C = (st & 1) * 32 + (swz % 64) / 2; }
__host__ __device__ __forceinline__ int perm32(int rho) { const int n = rho >> 4, i = rho & 15; return 8 * (i >> 2) + 4 * n + (i & 3); }

struct Unit { int pm, pn; };
struct Gemm { const bf16_t* A; const bf16_t* Bt; int M, N, K, lda; };

struct StaticOrder {
    int nM, nN, nwg, G, c;
    __host__ __device__ void init(int M, int N, int G_, int c_) { nM = M / BM; nN = N / BM; nwg = nM * nN; G = G_; c = c_; }
    __host__ __device__ bool next(int i, Unit& u) const {
        const long L = (long)i * G + c; if (L >= nwg) return false;
        int wgid = (int)L; { const int q = nwg / NXCD, r = nwg % NXCD, xcd = wgid % NXCD, off = wgid / NXCD; wgid = (xcd < r ? xcd * (q + 1) : r * (q + 1) + (xcd - r) * q) + off; }
        const int nig = WGM * nN, gid = wgid / nig, fm = gid * WGM, gsz = (nM - fm) < WGM ? (nM - fm) : WGM;
        u.pm = fm + ((wgid % nig) % gsz); u.pn = (wgid % nig) / gsz; return true;
    }
};

template <class Epi, class Sched>
__device__ __forceinline__ void gemm_phase(LAS unsigned char* lds, const Gemm g, const Sched& S, const Epi& E) {
    const int tid = threadIdx.x, wid = __builtin_amdgcn_readfirstlane(tid >> 6), lane = tid & 63, wr = wid >> 2, wc = wid & 3, fr = lane & 15, fq = lane >> 4;
    const int K = g.K, nt = K / BK, lda = g.lda;
    unsigned voffA[2], voffB[2];
#pragma unroll
    for (int i = 0; i < 2; ++i) { int R, C; stage_rc(tid * 16 + i * 8192, R, C); const int Rb = (R & ~31) + perm32(R & 31);
        voffA[i] = (unsigned)(R * lda + C) * 2u; voffB[i] = (unsigned)(Rb * K + C) * 2u; }
    const size_t kstep = (size_t)(BK * 2);
    const size_t hstepA = (size_t)HALF * lda * 2, hstepB = (size_t)HALF * K * 2;
    const size_t tstepA = 2 * hstepA, tstepB = 2 * hstepB;
    const unsigned ldsw = (unsigned)wid * 1024u;
    const int aoff = lds_byte(wr * 64 + fr, fq * 8), boff = lds_byte(wc * 32 + fr, fq * 8);
#define PG8_SA(b, h) (((b) * 2 + (h)) * HTB)
#define PG8_SB(b, h) ((4 + (b) * 2 + (h)) * HTB)
#define PG8_STAGE(bufoff, gbase, voff) do { _Pragma("unroll") for (int _i = 0; _i < 2; ++_i) \
        __builtin_amdgcn_global_load_lds((const unsigned*)((const char*)(gbase) + (voff)[_i]), (LAS unsigned*)(lds + (bufoff) + ldsw + _i * 8192), 16, 0, 0); } while (0)
#define PG8_LDA(dst, b, h) do { _Pragma("unroll") for (int m = 0; m < 4; ++m) _Pragma("unroll") for (int k = 0; k < 2; ++k) dst[m][k] = *(const LAS bf16x8*)(lds + PG8_SA(b, h) + aoff + m * 2048 + k * 1024); } while (0)
#define PG8_LDB(dst, b, h) do { _Pragma("unroll") for (int n = 0; n < 2; ++n) _Pragma("unroll") for (int k = 0; k < 2; ++k) dst[n][k] = *(const LAS bf16x8*)(lds + PG8_SB(b, h) + boff + n * 2048 + k * 1024); } while (0)
#define PG8_MMA(ai, bj, At, Bt) do { __builtin_amdgcn_s_setprio(1); _Pragma("unroll") for (int m = 0; m < 4; ++m) _Pragma("unroll") for (int n = 0; n < 2; ++n) _Pragma("unroll") for (int k = 0; k < 2; ++k) \
        acc[ai][bj][m][n] = __builtin_amdgcn_mfma_f32_16x16x32_bf16(Bt[n][k], At[m][k], acc[ai][bj][m][n], 0, 0, 0); __builtin_amdgcn_s_setprio(0); } while (0)
#define PG8_WAIT_V(n) asm volatile("s_waitcnt vmcnt(" #n ")" ::: "memory")
#define PG8_WAIT_L(n) asm volatile("s_waitcnt lgkmcnt(" #n ")" ::: "memory")
#define PG8_BAR __builtin_amdgcn_s_barrier()
#define PG8_SCHED __builtin_amdgcn_sched_barrier(0)
    Unit cur, nxt; int ui = 0;
    if (!S.next(0, cur)) return;
    f32x4 acc[2][2][4][2];
#pragma unroll
    for (int a = 0; a < 2; ++a)
#pragma unroll
        for (int b = 0; b < 2; ++b)
#pragma unroll
            for (int m = 0; m < 4; ++m)
#pragma unroll
                for (int n = 0; n < 2; ++n) acc[a][b][m][n] = (f32x4){0.f, 0.f, 0.f, 0.f};
    bf16x8 At[4][2], B0[2][2], B1[2][2];
    const char* cA = (const char*)g.A + (size_t)cur.pm * tstepA; const char* cB = (const char*)g.Bt + (size_t)cur.pn * tstepB;
    PG8_STAGE(PG8_SB(0, 0), cB, voffB); PG8_STAGE(PG8_SB(0, 1), cB + hstepB, voffB); PG8_STAGE(PG8_SA(0, 0), cA, voffA); PG8_STAGE(PG8_SA(0, 1), cA + hstepA, voffA);
    if (wr == 1) PG8_BAR;
    PG8_WAIT_V(2); PG8_BAR;
    PG8_STAGE(PG8_SB(1, 0), cB + kstep, voffB); PG8_STAGE(PG8_SA(1, 0), cA + kstep, voffA); PG8_STAGE(PG8_SB(1, 1), cB + hstepB + kstep, voffB);
    PG8_WAIT_V(6); PG8_BAR;
    for (;;) {
        const bool has_next = S.next(ui + 1, nxt);
        const char* nA = has_next ? (const char*)g.A + (size_t)nxt.pm * tstepA : cA; const char* nB = has_next ? (const char*)g.Bt + (size_t)nxt.pn * tstepB : cB;
#pragma unroll 1
        for (int t = 0; t < nt; t += 2) {
            const bool last = (t == nt - 2);
            const char* a1 = cA + (size_t)(t + 1) * kstep;
            const char* a2 = last ? nA : cA + (size_t)(t + 2) * kstep; const char* b2 = last ? nB : cB + (size_t)(t + 2) * kstep;
            const char* a3 = a2 + kstep; const char* b3 = b2 + kstep;
            PG8_LDB(B0, 0, 0); PG8_LDB(B1, 0, 1); PG8_SCHED; PG8_LDA(At, 0, 0); PG8_STAGE(PG8_SA(1, 1), a1 + hstepA, voffA);
            PG8_WAIT_V(8); PG8_WAIT_L(0); PG8_BAR; PG8_MMA(0, 0, At, B0); PG8_MMA(0, 1, At, B1); PG8_BAR; PG8_SCHED;
            PG8_LDA(At, 0, 1); PG8_STAGE(PG8_SB(0, 0), b2, voffB); PG8_STAGE(PG8_SB(0, 1), b2 + hstepB, voffB); PG8_STAGE(PG8_SA(0, 0), a2, voffA);
            PG8_WAIT_V(8); PG8_WAIT_L(0); PG8_BAR; PG8_MMA(1, 0, At, B0); PG8_MMA(1, 1, At, B1); PG8_BAR; PG8_SCHED;
            PG8_LDB(B0, 1, 0); PG8_LDB(B1, 1, 1); PG8_SCHED; PG8_LDA(At, 1, 0); PG8_STAGE(PG8_SA(0, 1), a2 + hstepA, voffA);
            PG8_WAIT_V(8); PG8_WAIT_L(0); PG8_BAR; PG8_MMA(0, 0, At, B0); PG8_MMA(0, 1, At, B1); PG8_BAR; PG8_SCHED;
            PG8_LDA(At, 1, 1); PG8_STAGE(PG8_SB(1, 0), b3, voffB); PG8_STAGE(PG8_SB(1, 1), b3 + hstepB, voffB); PG8_STAGE(PG8_SA(1, 0), a3, voffA);
            PG8_WAIT_V(8); PG8_WAIT_L(0); PG8_BAR; PG8_MMA(1, 0, At, B0); PG8_MMA(1, 1, At, B1); PG8_BAR; PG8_SCHED;
        }
        if (wr == 0) PG8_BAR;
        E(acc, cur, wr, wc, fr, fq);
        if (!has_next) break;
#pragma unroll
        for (int a = 0; a < 2; ++a)
#pragma unroll
            for (int b = 0; b < 2; ++b)
#pragma unroll
                for (int m = 0; m < 4; ++m)
#pragma unroll
                    for (int n = 0; n < 2; ++n) acc[a][b][m][n] = (f32x4){0.f, 0.f, 0.f, 0.f};
        cur = nxt; cA = nA; cB = nB; ++ui;
        if (wr == 1) PG8_BAR;
    }
    PG8_WAIT_V(0);
    PG8_BAR;
#undef PG8_SA
#undef PG8_SB
#undef PG8_STAGE
#undef PG8_LDA
#undef PG8_LDB
#undef PG8_MMA
#undef PG8_WAIT_V
#undef PG8_WAIT_L
#undef PG8_BAR
#undef PG8_SCHED
}
}

constexpr int NWAVES_C = 8;
typedef f32x4 AccT[2][2][4][2];
__device__ __forceinline__ u32x4 pack8(const f32x4 a, const f32x4 b) { u32x4 w; w.x = cvtpk(a[0], a[1]); w.y = cvtpk(a[2], a[3]); w.z = cvtpk(b[0], b[1]); w.w = cvtpk(b[2], b[3]); return w; }
__device__ __forceinline__ float sq4(const f32x4 a) { return (a[0] * a[0] + a[1] * a[1]) + (a[2] * a[2] + a[3] * a[3]); }
__device__ __forceinline__ float red_fq(float s) { s += __shfl_xor(s, 16); s += __shfl_xor(s, 32); return s; }

struct EpiIn {
    bf16_t* Z; bf16_t* DKI; bf16_t* DVI; float* SSQ; float* SSKV; float* KRR; float* KRSS; const float* rope; const float* gdq; const float* gdk; const float* gmk;
    __device__ __forceinline__ void operator()(const AccT& acc, const pg8::Unit& u, int wr, int wc, int fr, int fq) const {
        const int pn = u.pn, row0 = u.pm * 256 + wr * 64 + fr;
        if (pn >= 6) {
#pragma unroll
            for (int ai = 0; ai < 2; ++ai)
#pragma unroll
                for (int m = 0; m < 4; ++m) { const int row = row0 + ai * 128 + m * 16, b = row >> 13, sq = row & (SEQ - 1);
#pragma unroll
                    for (int bj = 0; bj < 2; ++bj) { const int p = (pn - 6) * 256 + bj * 128 + wc * 32 + 8 * fq;
                        *(u32x4*)(DVI + vimg(4, b * 4 + (p >> 7), sq >> 6, (p & 127) >> 5, (sq & 63) >> 4, sq & 15, p & 31)) = pack8(acc[ai][bj][m][0], acc[ai][bj][m][1]); } }
        } else if (pn == 0) {
#pragma unroll
            for (int ai = 0; ai < 2; ++ai)
#pragma unroll
                for (int m = 0; m < 4; ++m) { const int row = row0 + ai * 128 + m * 16; bf16_t* rp = Z + (size_t)row * ZLD + pn * 256 + wc * 32 + 8 * fq; float s = 0.f;
#pragma unroll
                    for (int bj = 0; bj < 2; ++bj) { *(u32x4*)(rp + bj * 128) = pack8(acc[ai][bj][m][0], acc[ai][bj][m][1]); s += sq4(acc[ai][bj][m][0]) + sq4(acc[ai][bj][m][1]); }
                    if (pn == 0) { s = red_fq(s); if (fq == 0) SSQ[(size_t)row * 4 + wc] = s; } }
        } else if (pn == 1) {
#pragma unroll
            for (int ai = 0; ai < 2; ++ai)
#pragma unroll
                for (int m = 0; m < 4; ++m) { const int row = row0 + ai * 128 + m * 16;
                    *(u32x4*)(Z + (size_t)row * ZLD + 256 + wc * 32 + 8 * fq) = pack8(acc[ai][0][m][0], acc[ai][0][m][1]);
                    float s = red_fq(sq4(acc[ai][0][m][0]) + sq4(acc[ai][0][m][1])); if (fq == 0) SSKV[(size_t)row * 4 + wc] = s;
                    if (wc == 0) {
                        const f32x4 v0 = acc[ai][1][m][0], v1 = acc[ai][1][m][1];
                        float ss = red_fq(sq4(v0) + sq4(v1)); if (fq == 0) KRSS[row] = ss;
                        const f32x4 g0 = *(const f32x4*)(gmk + 64 + 8 * fq), g1 = *(const f32x4*)(gmk + 64 + 8 * fq + 4);
                        const f32x4 a0 = v0 * g0, a1 = v1 * g1;
                        f32x4 b0, b1;
#pragma unroll
                        for (int e = 0; e < 4; ++e) { b0[e] = __shfl_xor(a0[e], 32); b1[e] = __shfl_xor(a1[e], 32); }
                        const int pos = row & (SEQ - 1); const float* rp = rope + (size_t)pos * 32 + 8 * (fq & 1);
                        const f32x4 c0 = *(const f32x4*)(rp), c1 = *(const f32x4*)(rp + 4), s0 = *(const f32x4*)(rp + 16), s1 = *(const f32x4*)(rp + 20);
                        f32x4 o0, o1;
                        if (fq < 2) { o0 = a0 * c0 - b0 * s0; o1 = a1 * c1 - b1 * s1; } else { o0 = a0 * c0 + b0 * s0; o1 = a1 * c1 + b1 * s1; }
                        *(f32x4*)(KRR + (size_t)row * 32 + 8 * fq) = o0; *(f32x4*)(KRR + (size_t)row * 32 + 8 * fq + 4) = o1;
                    } }
        } else {
            const bool isq = pn < 4; const float* g = isq ? gdq : gdk; const float sc = isq ? 0.125f * LOG2E : 1.0f;
            const int G = 4 * ((pn - 2) & 1) + wc; const int colb = Z_DQ + 64 * G + 8 * fq;
            f32x4 gg[2][2];
#pragma unroll
            for (int bj = 0; bj < 2; ++bj) { gg[bj][0] = *(const f32x4*)(g + 32 * bj + 8 * fq) * sc; gg[bj][1] = *(const f32x4*)(g + 32 * bj + 8 * fq + 4) * sc; }
#pragma unroll
            for (int ai = 0; ai < 2; ++ai)
#pragma unroll
                for (int m = 0; m < 4; ++m) { const int row = row0 + ai * 128 + m * 16;
                    float s = (sq4(acc[ai][0][m][0]) + sq4(acc[ai][0][m][1])) + (sq4(acc[ai][1][m][0]) + sq4(acc[ai][1][m][1])); s = red_fq(s);
                    const float r = rsqrtf(s * (1.0f / 64.0f) + EPS);
#pragma unroll
                    for (int bj = 0; bj < 2; ++bj) { const u32x4 w = pack8(acc[ai][bj][m][0] * gg[bj][0] * r, acc[ai][bj][m][1] * gg[bj][1] * r);
                        if (isq) *(u32x4*)(Z + (size_t)row * ZLD + colb + 32 * bj) = w;
                        else *(u32x4*)(DKI + kimg(8, (row >> 13) * 8 + G, (row & (SEQ - 1)) >> 6, 4 * bj + fq, row & 63)) = w; } }
        }
    }
};

template <bool KV> struct EpiUp {
    bf16_t* QR; bf16_t* KM; bf16_t* VM; const float* SSQ; const float* SSKV; const float* KRR; const float* KRSS; const float* gmk;
    __device__ __forceinline__ void operator()(const AccT& acc, const pg8::Unit& u, int wr, int wc, int fr, int fq) const {
        const int pn = u.pn, row0 = u.pm * 256 + wr * 64 + fr;
        if (!KV || pn >= 2) {
            const float* SSp = KV ? SSKV : SSQ; const float inv = KV ? (1.0f / 128.0f) : (1.0f / 256.0f);
#pragma unroll
            for (int ai = 0; ai < 2; ++ai)
#pragma unroll
                for (int m = 0; m < 4; ++m) { const int row = row0 + ai * 128 + m * 16;
                    const f32x4 s4 = *(const f32x4*)(SSp + (size_t)row * 4); const float r = rsqrtf(((s4[0] + s4[1]) + (s4[2] + s4[3])) * inv + EPS);
#pragma unroll
                    for (int bj = 0; bj < 2; ++bj) { const u32x4 w = pack8(acc[ai][bj][m][0] * r, acc[ai][bj][m][1] * r);
                        if (!KV) *(u32x4*)(QR + (size_t)row * 768 + pn * 256 + bj * 128 + wc * 32 + 8 * fq) = w;
                        else { const int p = (pn - 2) * 256 + bj * 128 + wc * 32 + 8 * fq, sq = row & (SEQ - 1);
                            *(u32x4*)(VM + vimg(2, (row >> 13) * 8 + (p >> 6), sq >> 6, (p & 63) >> 5, (sq & 63) >> 4, sq & 15, p & 31)) = w; } }
                    if (m & 1) asm volatile("" ::: "memory"); }
        } else {
            const int hh = 4 * pn + wc;
            f32x4 gg[2][2];
#pragma unroll
            for (int bj = 0; bj < 2; ++bj) { gg[bj][0] = *(const f32x4*)(gmk + 32 * bj + 8 * fq); gg[bj][1] = *(const f32x4*)(gmk + 32 * bj + 8 * fq + 4); }
#pragma unroll
            for (int ai = 0; ai < 2; ++ai)
#pragma unroll
                for (int m = 0; m < 4; ++m) { const int row = row0 + ai * 128 + m * 16;
                    const f32x4 s4 = *(const f32x4*)(SSKV + (size_t)row * 4); const float r = rsqrtf(((s4[0] + s4[1]) + (s4[2] + s4[3])) * (1.0f / 128.0f) + EPS);
                    float s = (sq4(acc[ai][0][m][0]) + sq4(acc[ai][0][m][1])) + (sq4(acc[ai][1][m][0]) + sq4(acc[ai][1][m][1]));
                    s = red_fq(s) * (r * r);
                    const float rk = rsqrtf((s + KRSS[row]) * (1.0f / 96.0f) + EPS), rr = r * rk;
                    const int bhk = (row >> 13) * 8 + hh, tk = (row & (SEQ - 1)) >> 6, rwk = row & 63;
#pragma unroll
                    for (int bj = 0; bj < 2; ++bj) *(u32x4*)(KM + kimg(12, bhk, tk, 4 * bj + fq, rwk)) = pack8(acc[ai][bj][m][0] * gg[bj][0] * rr, acc[ai][bj][m][1] * gg[bj][1] * rr);
                    const f32x4 k0 = *(const f32x4*)(KRR + (size_t)row * 32 + 8 * fq), k1 = *(const f32x4*)(KRR + (size_t)row * 32 + 8 * fq + 4);
                    *(u32x4*)(KM + kimg(12, bhk, tk, 8 + fq, rwk)) = pack8(k0 * rk, k1 * rk);
                    asm volatile("" ::: "memory"); }
        }
    }
};

template <bool XI_BF16> struct EpiRes {
    const void* xi; bf16_t* XB; float* SS;
    __device__ __forceinline__ void operator()(const AccT& acc, const pg8::Unit& u, int wr, int wc, int fr, int fq) const {
        const int row0 = u.pm * 256 + wr * 64 + fr, col0 = u.pn * 256 + wc * 32 + 8 * fq;
#pragma unroll
        for (int ai = 0; ai < 2; ++ai) {
            u32x4 rb[4][2]; f32x4 rf[4][2][2];
#pragma unroll
            for (int m = 0; m < 4; ++m) { const size_t off = (size_t)(row0 + ai * 128 + m * 16) * D_MODEL + col0;
#pragma unroll
                for (int bj = 0; bj < 2; ++bj) {
                    if constexpr (XI_BF16) rb[m][bj] = *(const u32x4*)((const bf16_t*)xi + off + bj * 128);
                    else { rf[m][bj][0] = *(const f32x4*)((const float*)xi + off + bj * 128); rf[m][bj][1] = *(const f32x4*)((const float*)xi + off + bj * 128 + 4); } } }
#pragma unroll
            for (int m = 0; m < 4; ++m) { const int row = row0 + ai * 128 + m * 16; const size_t off = (size_t)row * D_MODEL + col0; float s = 0.f;
#pragma unroll
                for (int bj = 0; bj < 2; ++bj) { f32x4 a, b;
                    if constexpr (XI_BF16) { const u32x4 w = rb[m][bj]; a = (f32x4){bflo(w.x), bfhi(w.x), bflo(w.y), bfhi(w.y)}; b = (f32x4){bflo(w.z), bfhi(w.z), bflo(w.w), bfhi(w.w)}; }
                    else { a = rf[m][bj][0]; b = rf[m][bj][1]; }
                    a += acc[ai][bj][m][0]; b += acc[ai][bj][m][1];
                    *(u32x4*)(XB + off + bj * 128) = pack8(a, b); s += sq4(a) + sq4(b); }
                s = red_fq(s); if (fq == 0) SS[(size_t)row * 16 + u.pn * 4 + wc] = s; }
            asm volatile("" ::: "memory"); }
    }
};
__device__ __forceinline__ float rstd_from16(const float* SS, int row, int fq) {
    const f32x4 s4 = *(const f32x4*)(SS + (size_t)row * 16 + 4 * fq); const float s = red_fq((s4[0] + s4[1]) + (s4[2] + s4[3]));
    return rsqrtf(s * (1.0f / 1024.0f) + EPS);
}
struct EpiGate {
    bf16_t* Gt; const float* SS;
    __device__ __forceinline__ void operator()(const AccT& acc, const pg8::Unit& u, int wr, int wc, int fr, int fq) const {
        const int row0 = u.pm * 256 + wr * 64 + fr, col0 = u.pn * 256 + wc * 32 + 8 * fq;
#pragma unroll
        for (int ai = 0; ai < 2; ++ai)
#pragma unroll
            for (int m = 0; m < 4; ++m) { const int row = row0 + ai * 128 + m * 16; const float r = rstd_from16(SS, row, fq);
#pragma unroll
                for (int bj = 0; bj < 2; ++bj) *(u32x4*)(Gt + (size_t)row * D_FF + col0 + bj * 128) = pack8(acc[ai][bj][m][0] * r, acc[ai][bj][m][1] * r); }
    }
};
template <int CTRL> __device__ __forceinline__ unsigned dpp_ror(unsigned v) { return (unsigned)__builtin_amdgcn_mov_dpp((int)v, CTRL, 0xf, 0xf, false); }
struct EpiUpAct {
    const bf16_t* Gt; bf16_t* ACT; const float* SS; const float* cw; const float* cb;
    __device__ __forceinline__ void operator()(const AccT& acc, const pg8::Unit& u, int wr, int wc, int fr, int fq) const {
#pragma unroll
        for (int bj = 0; bj < 2; ++bj) { const int col = u.pn * 256 + bj * 128 + wc * 32 + 8 * fq;
            float w0[8], w1[8], w2[8], bb[8];
#pragma unroll
            for (int h = 0; h < 2; ++h) { const f32x4 a = *(const f32x4*)(cw + col + 4 * h), b = *(const f32x4*)(cw + D_FF + col + 4 * h), c = *(const f32x4*)(cw + 2 * D_FF + col + 4 * h), d = *(const f32x4*)(cb + col + 4 * h);
#pragma unroll
                for (int e = 0; e < 4; ++e) { w0[4 * h + e] = -LOG2E * a[e]; w1[4 * h + e] = -LOG2E * b[e]; w2[4 * h + e] = -LOG2E * c[e]; bb[4 * h + e] = -LOG2E * d[e]; } }
#pragma unroll
            for (int ai = 0; ai < 2; ++ai) { const int strip0 = u.pm * 256 + ai * 128 + wr * 64;
                const bool seq0 = (strip0 & (SEQ - 1)) == 0;
                u32x4 g[5];
                g[0] = (u32x4){0u, 0u, 0u, 0u};
                if (!seq0) g[0] = *(const u32x4*)(Gt + (size_t)(strip0 - 16 + fr) * D_FF + col);
#pragma unroll
                for (int m = 0; m < 4; ++m) g[m + 1] = *(const u32x4*)(Gt + (size_t)(strip0 + 16 * m + fr) * D_FF + col);
#pragma unroll
                for (int m = 0; m < 4; ++m) { const int row = strip0 + 16 * m + fr; const float r = rstd_from16(SS, row, fq) * (-0.6931471805599453f);
                    float uu[8]; { const f32x4 a = acc[ai][bj][m][0] * r, b = acc[ai][bj][m][1] * r;
#pragma unroll
                        for (int e = 0; e < 4; ++e) { uu[e] = a[e]; uu[4 + e] = b[e]; } }
                    float o[8];
#pragma unroll
                    for (int w = 0; w < 4; ++w) { const unsigned x2 = g[m + 1][w];
                        const unsigned x1 = (unsigned)__builtin_amdgcn_update_dpp((int)dpp_ror<0x121>(g[m][w]), (int)g[m + 1][w], 0x111, 0xf, 0xf, false);
                        const unsigned x0 = (unsigned)__builtin_amdgcn_update_dpp((int)dpp_ror<0x122>(g[m][w]), (int)g[m + 1][w], 0x112, 0xf, 0xf, false);
#pragma unroll
                        for (int hh = 0; hh < 2; ++hh) { const int e = 2 * w + hh; const float a0 = hh ? bfhi(x0) : bflo(x0), a1 = hh ? bfhi(x1) : bflo(x1), a2 = hh ? bfhi(x2) : bflo(x2);
                            const float t = bb[e] + w0[e] * a0 + w1[e] * a1 + w2[e] * a2;
                            o[e] = t * __builtin_amdgcn_rcpf(1.0f + __builtin_amdgcn_exp2f(t)) * uu[e]; } }
                    u32x4 wv; wv.x = cvtpk(o[0], o[1]); wv.y = cvtpk(o[2], o[3]); wv.z = cvtpk(o[4], o[5]); wv.w = cvtpk(o[6], o[7]);
                    *(u32x4*)(ACT + (size_t)row * D_FF + col) = wv; } } }
    }
};
struct EpiBf {
    bf16_t* O;
    __device__ __forceinline__ void operator()(const AccT& acc, const pg8::Unit& u, int wr, int wc, int fr, int fq) const {
        const int row0 = u.pm * 256 + wr * 64 + fr, col0 = u.pn * 256 + wc * 32 + 8 * fq;
#pragma unroll
        for (int ai = 0; ai < 2; ++ai)
#pragma unroll
            for (int m = 0; m < 4; ++m) { const size_t off = (size_t)(row0 + ai * 128 + m * 16) * D_MODEL + col0;
#pragma unroll
                for (int bj = 0; bj < 2; ++bj) *(u32x4*)(O + off + bj * 128) = pack8(acc[ai][bj][m][0], acc[ai][bj][m][1]); }
    }
};
struct EpiPle {
    float* xo; const bf16_t* X2; const bf16_t* PR; const float* SS;
    __device__ __forceinline__ void operator()(const AccT& acc, const pg8::Unit& u, int wr, int wc, int fr, int fq) const {
        const int row0 = u.pm * 256 + wr * 64 + fr, col0 = u.pn * 256 + wc * 32 + 8 * fq;
#pragma unroll
        for (int ai = 0; ai < 2; ++ai) {
            u32x4 xw[4][2], pq[4][2]; float rr[4];
#pragma unroll
            for (int m = 0; m < 4; ++m) { const int row = row0 + ai * 128 + m * 16; const size_t off = (size_t)row * D_MODEL + col0; rr[m] = rstd_from16(SS, row, fq);
#pragma unroll
                for (int bj = 0; bj < 2; ++bj) { xw[m][bj] = *(const u32x4*)(X2 + off + bj * 128); pq[m][bj] = *(const u32x4*)(PR + off + bj * 128); } }
#pragma unroll
            for (int m = 0; m < 4; ++m) { const size_t off = (size_t)(row0 + ai * 128 + m * 16) * D_MODEL + col0; const float r = rr[m];
#pragma unroll
                for (int bj = 0; bj < 2; ++bj) { const size_t o2 = off + bj * 128;
#pragma unroll
                    for (int n = 0; n < 2; ++n) { const unsigned x0 = n ? xw[m][bj].z : xw[m][bj].x, x1 = n ? xw[m][bj].w : xw[m][bj].y, q0 = n ? pq[m][bj].z : pq[m][bj].x, q1 = n ? pq[m][bj].w : pq[m][bj].y;
                        const f32x4 x2 = (f32x4){bflo(x0), bfhi(x0), bflo(x1), bfhi(x1)}, pr = (f32x4){bflo(q0), bfhi(q0), bflo(q1), bfhi(q1)}; const f32x4 gt = acc[ai][bj][m][n] * r; f32x4 o;
#pragma unroll
                        for (int e = 0; e < 4; ++e) o[e] = x2[e] + pr[e] * __builtin_amdgcn_rcpf(1.0f + __builtin_amdgcn_exp2f(-gt[e] * LOG2E));
                        *(f32x4*)(xo + o2 + 4 * n) = o; } } }
            asm volatile("" ::: "memory"); }
    }
};

struct IdleOrder {
    int base, ic, nidle, count, ncol;
    __device__ bool next(int i, pg8::Unit& u) const { const int v = ic + nidle * i; if (ic < 0 || v >= count) return false; const int w = base + v; u.pm = w / ncol; u.pn = w % ncol; return true; }
};
struct PanelOrder {
    int base, ic, per, count;
    __device__ bool next(int i, pg8::Unit& u) const { const int v = per * ic + i; if (i >= per || v >= count) return false; const int w = base + v; u.pm = w >> 2; u.pn = w & 3; return true; }
};
__device__ __forceinline__ void convert_p_rows(const float* p_in, bf16_t* PB, int row0, int nrows, int tid) {
    const size_t e0 = (size_t)row0 * PLE_DIM / 8, n8 = (size_t)nrows * PLE_DIM / 8;
    for (size_t i = tid; i < n8; i += 4 * NWAVES_C * 64) { f32x4 a[4], b[4];
#pragma unroll
        for (int q = 0; q < 4; ++q) { const size_t ii = i + (size_t)q * NWAVES_C * 64; if (ii < n8) { a[q] = *(const GAS f32x4*)(p_in + (e0 + ii) * 8); b[q] = *(const GAS f32x4*)(p_in + (e0 + ii) * 8 + 4); } }
#pragma unroll
        for (int q = 0; q < 4; ++q) { const size_t ii = i + (size_t)q * NWAVES_C * 64; if (ii < n8) *(GAS u32x4*)(PB + (e0 + ii) * 8) = pack8(a[q], b[q]); } }
    asm volatile("s_waitcnt vmcnt(0)" ::: "memory"); __syncthreads();
}

namespace attn {
__device__ __forceinline__ int crow(int r, int hi) { return (r & 3) + 8 * (r >> 2) + 4 * hi; }
__device__ __forceinline__ void glds16(const void* gbase, unsigned voff, unsigned lds_dst) { unsigned keep;
    asm volatile("s_mov_b32 %0, m0\n\ts_mov_b32 m0, %2\n\ts_nop 0\n\tglobal_load_lds_dwordx4 %1, %3\n\ts_mov_b32 m0, %0" : "=&s"(keep) : "v"(voff), "s"(lds_dst), "s"(gbase) : "memory"); }
typedef LAS const char* lds_cptr;
__device__ __forceinline__ s16x4 vtr(lds_cptr p) { return __builtin_bit_cast(s16x4, __builtin_amdgcn_ds_read_tr16_b64_v4i16((LAS s16x4*)p)); }
#define AT_WAITBAR(N) asm volatile("s_waitcnt vmcnt(" #N ") lgkmcnt(0)\n\ts_barrier" ::: "memory")
#define AT_BAR() asm volatile("s_waitcnt lgkmcnt(0)\n\ts_barrier" ::: "memory")
#define AT_WAITBAR_NL(N) asm volatile("s_waitcnt vmcnt(" #N ")\n\ts_barrier" ::: "memory")

template <int NKS, int ND, int NKSL = 3> struct Cfg {
    static constexpr int KSLOT = NKS * 2048, VSLOT = ND * 4096, NCH = NKS * 2;
    static constexpr int LDS_K = 0, LDS_V = NKSL * KSLOT, LDS_WS = LDS_V + 3 * VSLOT, LDS_OST = LDS_WS + 2048, OSTW = ND * 2048, LDS_BIAS = LDS_OST + 8 * OSTW, LDS_END = LDS_BIAS + 4096;
    static constexpr int NKD = (NCH > 8) ? 2 : 1, NVD = (ND * 4) / 8, NDMA = NKD + NVD;
};
struct UnitP { const bf16_t* Q; int ldq; const bf16_t* K; int ldk; const bf16_t* V; int ldv; bf16_t* O; int ldo; int qb; long rowbase; const float* btab; const float* bound; const bf16_t* O1; bf16_t* Yc; const float* gout; const float* lamp; };

constexpr float THR = 8.0f;


template <int NKS, int ND, bool PV, bool QK> struct Ops {
    static constexpr int QCH = NKS / ND, B = (PV ? 4 : 0) + (QK ? 2 * QCH : 0), N = ND * B;
    static_assert(NKS % ND == 0, "k-steps split evenly over the d-blocks");
    __host__ __device__ static constexpr int kind(int i) { return (PV && (i % B) < 4) ? 0 : 1; }
    __host__ __device__ static constexpr int a(int i) { const int blk = i / B, j = i % B; return (PV && j < 4) ? blk : blk * QCH + (j - (PV ? 4 : 0)) / 2; }
    __host__ __device__ static constexpr int b(int i) { const int j = i % B; return (PV && j < 4) ? j : (j - (PV ? 4 : 0)) % 2; }
};
template <int NKS, int ND, bool PV, bool QK>
__device__ __forceinline__ void mfma_slot(f32x16 (&o)[ND], f32x16& p0, f32x16& p1, const u32x4 (&pw)[4], const bf16x8 (&qr)[NKS], const f32x16& negm, lds_cptr kp, lds_cptr vp) {
    typedef Ops<NKS, ND, PV, QK> OP;
    constexpr int AT_D = (ND >= 4) ? 6 : 8;
    s16x4 flo[AT_D], fhi[AT_D];
#define AT_LOAD(i) do { if (OP::kind(i) == 0) { flo[(i) % AT_D] = vtr(vp + OP::a(i) * 4096 + OP::b(i) * 1024); fhi[(i) % AT_D] = vtr(vp + OP::a(i) * 4096 + OP::b(i) * 1024 + 512); } \
        else { const bf16x8 kk_ = *(const LAS bf16x8*)(kp + OP::a(i) * 2048 + OP::b(i) * 512); flo[(i) % AT_D] = (s16x4){kk_[0], kk_[1], kk_[2], kk_[3]}; fhi[(i) % AT_D] = (s16x4){kk_[4], kk_[5], kk_[6], kk_[7]}; } } while (0)
#pragma unroll
    for (int i = 0; i < AT_D && i < OP::N; ++i) AT_LOAD(i);
    __builtin_amdgcn_sched_barrier(0);
#pragma unroll
    for (int i = 0; i < OP::N; ++i) {
        const s16x4 lo = flo[i % AT_D], hh = fhi[i % AT_D];
        const bf16x8 f = (bf16x8){lo[0], lo[1], lo[2], lo[3], hh[0], hh[1], hh[2], hh[3]};
        if (OP::kind(i) == 0) o[OP::a(i)] = __builtin_amdgcn_mfma_f32_32x32x16_bf16(__builtin_bit_cast(bf16x8, pw[OP::b(i)]), f, o[OP::a(i)], 0, 0, 0);
        else if (OP::b(i) == 0) p0 = (OP::a(i) == 0) ? __builtin_amdgcn_mfma_f32_32x32x16_bf16(f, qr[0], negm, 0, 0, 0) : __builtin_amdgcn_mfma_f32_32x32x16_bf16(f, qr[OP::a(i)], p0, 0, 0, 0);
        else p1 = (OP::a(i) == 0) ? __builtin_amdgcn_mfma_f32_32x32x16_bf16(f, qr[0], negm, 0, 0, 0) : __builtin_amdgcn_mfma_f32_32x32x16_bf16(f, qr[OP::a(i)], p1, 0, 0, 0);
        if (i + AT_D < OP::N) AT_LOAD(i + AT_D);
        __builtin_amdgcn_sched_barrier(0);
    }

#undef AT_LOAD
}

template <int NKS, int ND, bool MLA>
__device__ __forceinline__ void attn_unit(const UnitP& P, LAS unsigned char* lds, const float* __restrict__ rope, const float* __restrict__ gq) {
    typedef Cfg<NKS, ND> C;
    int tid = threadIdx.x; asm volatile("" : "+v"(tid));
    const int lane = tid & 63, r32 = lane & 31, hi = lane >> 5; const int wid = __builtin_amdgcn_readfirstlane(tid >> 6);
    const int grp = wid >> 2, q0 = P.qb * 256, NT = 4 * P.qb + 4, tmax = 4 * P.qb + (wid >> 1);
    bf16x8 qr[NKS];
    { const bf16_t* Qw = P.Q + (size_t)(P.rowbase + q0 + wid * 32 + r32) * P.ldq + hi * 8;
      if constexpr (MLA) {
        float qf[NKS][8]; float ss = 0.f;
#pragma unroll
        for (int d0 = 0; d0 < NKS; ++d0) { const bf16x8 raw = *(const bf16x8*)(Qw + d0 * 16);
#pragma unroll
            for (int j = 0; j < 8; ++j) { qf[d0][j] = bf2f(raw[j]); ss += qf[d0][j] * qf[d0][j]; } }
        ss += __shfl_xor(ss, 32);
        const float r = rsqrtf(ss * (1.0f / 96.0f) + EPS);
#pragma unroll
        for (int d0 = 0; d0 < NKS; ++d0) { const f32x4 g0 = *(const f32x4*)(gq + 16 * d0 + 8 * hi), g1 = *(const f32x4*)(gq + 16 * d0 + 8 * hi + 4);
#pragma unroll
            for (int j = 0; j < 4; ++j) { qf[d0][j] *= r * g0[j]; qf[d0][4 + j] *= r * g1[j]; } }
        const int pos = q0 + wid * 32 + r32; const float* rp = rope + (size_t)pos * 32 + 8 * hi;
        const f32x4 c0 = *(const f32x4*)rp, c1 = *(const f32x4*)(rp + 4), s0 = *(const f32x4*)(rp + 16), s1 = *(const f32x4*)(rp + 20);
#pragma unroll
        for (int j = 0; j < 8; ++j) { const float c = j < 4 ? c0[j & 3] : c1[j & 3], s = j < 4 ? s0[j & 3] : s1[j & 3]; const float a = qf[4][j], b = qf[5][j]; qf[4][j] = a * c - b * s; qf[5][j] = b * c + a * s; }
        const float sc = 0.10206207261596577f * LOG2E;
#pragma unroll
        for (int d0 = 0; d0 < NKS; ++d0) { u32x4 w; w.x = cvtpk(qf[d0][0] * sc, qf[d0][1] * sc); w.y = cvtpk(qf[d0][2] * sc, qf[d0][3] * sc); w.z = cvtpk(qf[d0][4] * sc, qf[d0][5] * sc); w.w = cvtpk(qf[d0][6] * sc, qf[d0][7] * sc);
            qr[d0] = __builtin_bit_cast(bf16x8, w); }
      } else {
#pragma unroll
        for (int d0 = 0; d0 < NKS; ++d0) qr[d0] = *(const bf16x8*)(Qw + d0 * 16);
      } }
    LAS float* wsf = (LAS float*)(lds + C::LDS_WS) + wid * 64;
    const bool fixed_ref = __builtin_amdgcn_readfirstlane(__float_as_int(*P.bound)) < __float_as_int(64.0f) && *P.bound >= 0.f;
    if constexpr (!MLA) { LAS float* tb = (LAS float*)(lds + C::LDS_BIAS); tb[tid] = P.btab[tid]; tb[tid + 512] = P.btab[tid + 512]; }
    asm volatile("s_waitcnt vmcnt(0)" ::: "memory");
    const unsigned lds0 = (unsigned)(size_t)lds;
    const bf16_t* kbase = P.K; const bf16_t* vbase = P.V;
    const unsigned koff0 = (unsigned)(wid * 1024 + lane * 16), koff1 = (unsigned)((8 + (wid & 3)) * 1024 + lane * 16);
    const unsigned kdst0 = lds0 + C::LDS_K + wid * 1024, kdst1 = lds0 + C::LDS_K + (8 + (wid & 3)) * 1024;
    const unsigned voff0 = (unsigned)(wid * 1024 + lane * 16), voff1 = voff0 + 8192u;
    const unsigned vdst0 = lds0 + C::LDS_V + wid * 1024, vdst1 = vdst0 + 8192;
    const size_t ktile = (size_t)C::KSLOT / 2, vtile = (size_t)C::VSLOT / 2;
#define DMA_K(t, slotoff) do { const bf16_t* kb_ = kbase + (size_t)(t) * ktile; glds16(kb_, koff0, (unsigned)__builtin_amdgcn_readfirstlane(kdst0 + (slotoff))); \
        if constexpr (C::NKD == 2) { if (grp == 0) glds16(kb_, koff1, (unsigned)__builtin_amdgcn_readfirstlane(kdst1 + (slotoff))); } } while (0)
#define DMA_V(t, slotoff) do { const bf16_t* vb_ = vbase + (size_t)(t) * vtile; glds16(vb_, voff0, (unsigned)__builtin_amdgcn_readfirstlane(vdst0 + (slotoff))); \
        if constexpr (C::NVD == 2) glds16(vb_, voff1, (unsigned)__builtin_amdgcn_readfirstlane(vdst1 + (slotoff))); } while (0)
    const lds_cptr kp0 = (lds_cptr)lds + C::LDS_K + hi * 1024 + r32 * 16;
    const lds_cptr vp0 = (lds_cptr)lds + C::LDS_V + ((lane >> 4) & 1) * 32 + (lane & 3) * 8 + (4 * hi + ((lane & 15) >> 2)) * 64;
    DMA_K(0, 0); DMA_K(1, C::KSLOT); DMA_V(0, 0);
    static_assert(C::NDMA == 3, "three LDS-DMA pieces per wave per tile");
    if (C::NKD == 2 && grp == 1) { AT_WAITBAR(2); } else { AT_WAITBAR(3); }
    float mhat = 0.f, l_reg = 0.f; f32x16 o[ND]; f32x16 negm = f32x16{}; f32x16 p0 = f32x16{}, p1 = f32x16{}; u32x4 pw[4];
#pragma unroll
    for (int d = 0; d < ND; ++d) o[d] = f32x16{};
#pragma unroll
    for (int k = 0; k < 4; ++k) pw[k] = (u32x4){0u, 0u, 0u, 0u};
#if defined(PROBE_MFMA2)
    f32x16 od_[ND], dp0_ = f32x16{}, dp1_ = f32x16{};
#pragma unroll
    for (int d = 0; d < ND; ++d) od_[d] = f32x16{};
#endif
    int ks0 = 0, ks1 = C::KSLOT, ks2 = 2 * C::KSLOT;
    int vsm = 2 * C::VSLOT, vs0 = 0, vs1 = C::VSLOT;
    if (grp == 1) AT_BAR();
    for (int t = 0; t <= NT; ++t) {
        const bool gk = t + 2 < NT, gv = t + 1 < NT;
        { const bool do_pv = (t >= 1 && t - 1 <= tmax), do_qk = (t < NT && t <= tmax);
          const lds_cptr vp = vp0 + vsm, kp = kp0 + ks0;
          if (do_pv && do_qk) mfma_slot<NKS, ND, true, true>(o, p0, p1, pw, qr, negm, kp, vp);
          else if (do_qk) mfma_slot<NKS, ND, false, true>(o, p0, p1, pw, qr, negm, kp, vp);
          else if (do_pv) mfma_slot<NKS, ND, true, false>(o, p0, p1, pw, qr, negm, kp, vp); }
#if defined(PROBE_MFMA2)
        if constexpr (MLA) { const bool do_pv = (t >= 1 && t - 1 <= tmax), do_qk = (t < NT && t <= tmax); const lds_cptr vp = vp0 + vsm, kp = kp0 + ks0;
          if (do_pv && do_qk) { mfma_slot<NKS, ND, true, true>(od_, dp0_, dp1_, pw, qr, negm, kp, vp); asm volatile("" :: "v"(od_[0]), "v"(od_[1]), "v"(dp0_), "v"(dp1_)); } }
#endif
        if (t == NT) break;
        const int cnt = (gk ? C::NKD : 0) + (gv ? C::NVD : 0);
#define AT_CLOSE() do { if (cnt == 3) { AT_WAITBAR(3); } else if (cnt == 2) { AT_WAITBAR(2); } else if (cnt == 1) { AT_WAITBAR(1); } else { AT_WAITBAR(0); } } while (0)
        if (grp == 1) { AT_WAITBAR(0); } else AT_BAR();
        if (gk) DMA_K(t + 2, ks2);
        if (gv) DMA_V(t + 1, vs1);
        if (t <= tmax) {
            if constexpr (!MLA) {
                const int dmin = q0 + wid * 32 - 64 * t - 63;
                if (dmin < 559) { const LAS float* tb = (const LAS float*)(lds + C::LDS_BIAS) + (dmin + r32 + 63 + 63 - 4 * hi);
#pragma unroll
                    for (int r = 0; r < 16; ++r) { const int kk = (r & 3) + 8 * (r >> 2); p0[r] += tb[-kk]; p1[r] += tb[-kk - 32]; } }
            }
            if (!fixed_ref) {
            float a = fmaxf(fmaxf(p0[0], p0[1]), p1[0]), b = fmaxf(fmaxf(p0[2], p0[3]), p1[1]); a = fmaxf(fmaxf(a, p1[2]), p1[3]);
#pragma unroll
            for (int r = 4; r < 16; r += 4) { a = fmaxf(fmaxf(a, p0[r]), p0[r + 1]); b = fmaxf(fmaxf(b, p0[r + 2]), p0[r + 3]); a = fmaxf(fmaxf(a, p1[r]), p1[r + 1]); b = fmaxf(fmaxf(b, p1[r + 2]), p1[r + 3]); }
            float rm = fmaxf(a, b); { auto rr = __builtin_amdgcn_permlane32_swap(__float_as_uint(rm), __float_as_uint(rm), false, false); rm = fmaxf(__uint_as_float(rr[0]), __uint_as_float(rr[1])); }
            if (t == 0 || __any(rm > THR)) {
                const float dl = (t == 0) ? rm : fmaxf(rm, 0.f); mhat += dl;
#pragma unroll
                for (int r = 0; r < 16; ++r) { p0[r] -= dl; p1[r] -= dl; }
#pragma unroll
                for (int r = 0; r < 16; ++r) negm[r] = -mhat;
                if (t != 0) { const float f = __builtin_amdgcn_exp2f(-dl); l_reg *= f; if (hi == 0) wsf[r32] = f;
                    asm volatile("s_waitcnt lgkmcnt(0)" ::: "memory");
#pragma unroll
                    for (int r = 0; r < 16; ++r) { const float fr_ = wsf[crow(r, hi)];
#pragma unroll
                        for (int d = 0; d < ND; ++d) o[d][r] *= fr_; } }
            }
            }
            float sacc = 0.f;
#pragma unroll
            for (int r = 0; r < 16; ++r) { p0[r] = __builtin_amdgcn_exp2f(p0[r]); p1[r] = __builtin_amdgcn_exp2f(p1[r]); sacc += p0[r] + p1[r]; }
            l_reg += sacc;
#if defined(PROBE_SM2)
            if constexpr (MLA) { float dsum_ = 0.f;
#pragma unroll
                for (int r = 0; r < 16; ++r) { dsum_ += __builtin_amdgcn_exp2f(p0[r] - 1.0f) + __builtin_amdgcn_exp2f(p1[r] - 1.0f); }
                asm volatile("" :: "v"(dsum_)); }
#endif
            pw[0] = (u32x4){cvtpk(p0[0], p0[1]), cvtpk(p0[2], p0[3]), cvtpk(p0[4], p0[5]), cvtpk(p0[6], p0[7])};
            pw[1] = (u32x4){cvtpk(p0[8], p0[9]), cvtpk(p0[10], p0[11]), cvtpk(p0[12], p0[13]), cvtpk(p0[14], p0[15])};
            pw[2] = (u32x4){cvtpk(p1[0], p1[1]), cvtpk(p1[2], p1[3]), cvtpk(p1[4], p1[5]), cvtpk(p1[6], p1[7])};
            pw[3] = (u32x4){cvtpk(p1[8], p1[9]), cvtpk(p1[10], p1[11]), cvtpk(p1[12], p1[13]), cvtpk(p1[14], p1[15])};
        }
        if (grp == 0) AT_CLOSE(); else AT_BAR();
        { const int k_ = ks0; ks0 = ks1; ks1 = ks2; ks2 = k_; const int v_ = vsm; vsm = vs0; vs0 = vs1; vs1 = v_; }
    }
    if (grp == 0) AT_BAR();
    { auto rr = __builtin_amdgcn_permlane32_swap(__float_as_uint(l_reg), __float_as_uint(l_reg), false, false); l_reg = __uint_as_float(rr[0]) + __uint_as_float(rr[1]); }
    if (hi == 0) wsf[32 + r32] = l_reg;
    asm volatile("s_waitcnt lgkmcnt(0)" ::: "memory");
    { int le = lane; asm volatile("" : "+v"(le));
      const int r32e = le & 31, hie = le >> 5;
      LAS bf16_t* stg = (LAS bf16_t*)(lds + C::LDS_OST + wid * C::OSTW);
      constexpr int RW = ND * 32;
#pragma unroll
      for (int r = 0; r < 16; ++r) { const int orow = (r & 3) + 8 * (r >> 2); const float rl = __builtin_amdgcn_rcpf(wsf[32 + 4 * hie + orow]);
#pragma unroll
          for (int d0 = 0; d0 < ND; ++d0) { const unsigned w = cvtpk(o[d0][r] * rl, 0.f); stg[(4 * hie + r32e) + orow * RW + d0 * 32 + (RW - 1) * 4 * hie] = (bf16_t)(w & 0xffffu); } }
      asm volatile("s_waitcnt lgkmcnt(0)" ::: "memory");
      constexpr int CPR = ND * 4, RPI = 64 / CPR;
      const int rowl = le / CPR, ch = le % CPR;
      const LAS bf16_t* sp = stg + rowl * RW + ch * 8;
      bf16_t* Ow = P.O + (size_t)(P.rowbase + q0 + wid * 32 + rowl) * P.ldo + ch * 8;
      if (MLA || P.O1 == nullptr) {
#pragma unroll
          for (int i = 0; i < ND * 2; ++i) { const u32x4 v = *(const LAS u32x4*)(sp + i * RPI * RW); *(u32x4*)(Ow + (size_t)(i * RPI) * P.ldo) = v; }
      } else {
          const float lam = *P.lamp; const f32x4 g0 = *(const f32x4*)(P.gout + ch * 8) * 0.8f, g1 = *(const f32x4*)(P.gout + ch * 8 + 4) * 0.8f;
          const bf16_t* O1p = P.O1 + (size_t)(P.rowbase + q0 + wid * 32 + rowl) * 1024 + ch * 8; bf16_t* Yp = P.Yc + (size_t)(P.rowbase + q0 + wid * 32 + rowl) * 1024 + ch * 8;
#pragma unroll
          for (int i = 0; i < ND * 2; ++i) { const u32x4 v2 = *(const LAS u32x4*)(sp + i * RPI * RW); const u32x4 v1 = *(const u32x4*)(O1p + (size_t)(i * RPI) * 1024);
              f32x4 a = (f32x4){bflo(v1.x) - lam * bflo(v2.x), bfhi(v1.x) - lam * bfhi(v2.x), bflo(v1.y) - lam * bflo(v2.y), bfhi(v1.y) - lam * bfhi(v2.y)};
              f32x4 b = (f32x4){bflo(v1.z) - lam * bflo(v2.z), bfhi(v1.z) - lam * bfhi(v2.z), bflo(v1.w) - lam * bflo(v2.w), bfhi(v1.w) - lam * bfhi(v2.w)};
              float ss = sq4(a) + sq4(b); ss += __shfl_xor(ss, 1); ss += __shfl_xor(ss, 2); ss += __shfl_xor(ss, 4); ss += __shfl_xor(ss, 8);
              const float r = rsqrtf(ss * (1.0f / 128.0f) + EPS);
              *(u32x4*)(Yp + (size_t)(i * RPI) * 1024) = pack8(a * g0 * r, b * g1 * r); }
      } }
    AT_BAR();
#undef DMA_K
#undef DMA_V
#undef AT_CLOSE
}

template <int NKS, int ND, bool MLA>
__device__ __forceinline__ void attn_unit_iw(const UnitP& P, LAS unsigned char* lds, const float* __restrict__ rope, const float* __restrict__ gq) {
    typedef Cfg<NKS, ND, 4> C;
    int tid = threadIdx.x; asm volatile("" : "+v"(tid));
    const int lane = tid & 63, r32 = lane & 31, hi = lane >> 5; const int wid = __builtin_amdgcn_readfirstlane(tid >> 6);
    const int grp = wid >> 2, q0 = P.qb * 256, NT = 4 * P.qb + 4, tmax = 4 * P.qb + (wid >> 1);
    bf16x8 qr[NKS];
    { const bf16_t* Qw = P.Q + (size_t)(P.rowbase + q0 + wid * 32 + r32) * P.ldq + hi * 8;
      if constexpr (MLA) {
        float qf[NKS][8]; float ss = 0.f;
#pragma unroll
        for (int d0 = 0; d0 < NKS; ++d0) { const bf16x8 raw = *(const bf16x8*)(Qw + d0 * 16);
#pragma unroll
            for (int j = 0; j < 8; ++j) { qf[d0][j] = bf2f(raw[j]); ss += qf[d0][j] * qf[d0][j]; } }
        ss += __shfl_xor(ss, 32);
        const float r = rsqrtf(ss * (1.0f / 96.0f) + EPS);
#pragma unroll
        for (int d0 = 0; d0 < NKS; ++d0) { const f32x4 g0 = *(const f32x4*)(gq + 16 * d0 + 8 * hi), g1 = *(const f32x4*)(gq + 16 * d0 + 8 * hi + 4);
#pragma unroll
            for (int j = 0; j < 4; ++j) { qf[d0][j] *= r * g0[j]; qf[d0][4 + j] *= r * g1[j]; } }
        const int pos = q0 + wid * 32 + r32; const float* rp = rope + (size_t)pos * 32 + 8 * hi;
        const f32x4 c0 = *(const f32x4*)rp, c1 = *(const f32x4*)(rp + 4), s0 = *(const f32x4*)(rp + 16), s1 = *(const f32x4*)(rp + 20);
#pragma unroll
        for (int j = 0; j < 8; ++j) { const float c = j < 4 ? c0[j & 3] : c1[j & 3], s = j < 4 ? s0[j & 3] : s1[j & 3]; const float a = qf[4][j], b = qf[5][j]; qf[4][j] = a * c - b * s; qf[5][j] = b * c + a * s; }
        const float sc = 0.10206207261596577f * LOG2E;
#pragma unroll
        for (int d0 = 0; d0 < NKS; ++d0) { u32x4 w; w.x = cvtpk(qf[d0][0] * sc, qf[d0][1] * sc); w.y = cvtpk(qf[d0][2] * sc, qf[d0][3] * sc); w.z = cvtpk(qf[d0][4] * sc, qf[d0][5] * sc); w.w = cvtpk(qf[d0][6] * sc, qf[d0][7] * sc);
            qr[d0] = __builtin_bit_cast(bf16x8, w); }
      } else {
#pragma unroll
        for (int d0 = 0; d0 < NKS; ++d0) qr[d0] = *(const bf16x8*)(Qw + d0 * 16);
      } }
    LAS float* wsf = (LAS float*)(lds + C::LDS_WS) + wid * 64;
    const bool fixed_ref = __builtin_amdgcn_readfirstlane(__float_as_int(*P.bound)) < __float_as_int(64.0f) && *P.bound >= 0.f;
    if constexpr (!MLA) { LAS float* tb = (LAS float*)(lds + C::LDS_BIAS); tb[tid] = P.btab[tid]; tb[tid + 512] = P.btab[tid + 512]; }
    asm volatile("s_waitcnt vmcnt(0)" ::: "memory");
    const unsigned lds0 = (unsigned)(size_t)lds;
    const bf16_t* kbase = P.K; const bf16_t* vbase = P.V;
    const unsigned koff0 = (unsigned)(wid * 1024 + lane * 16), koff1 = (unsigned)((8 + (wid & 3)) * 1024 + lane * 16);
    const unsigned kdst0 = lds0 + C::LDS_K + wid * 1024, kdst1 = lds0 + C::LDS_K + (8 + (wid & 3)) * 1024;
    const unsigned voff0 = (unsigned)(wid * 1024 + lane * 16), voff1 = voff0 + 8192u;
    const unsigned vdst0 = lds0 + C::LDS_V + wid * 1024, vdst1 = vdst0 + 8192;
    const size_t ktile = (size_t)C::KSLOT / 2, vtile = (size_t)C::VSLOT / 2;
#define DMA_K(t, slotoff) do { const bf16_t* kb_ = kbase + (size_t)(t) * ktile; glds16(kb_, koff0, (unsigned)__builtin_amdgcn_readfirstlane(kdst0 + (slotoff))); \
        if constexpr (C::NKD == 2) glds16(kb_, koff1, (unsigned)__builtin_amdgcn_readfirstlane(kdst1 + (slotoff))); } while (0)
#define DMA_V(t, slotoff) do { const bf16_t* vb_ = vbase + (size_t)(t) * vtile; glds16(vb_, voff0, (unsigned)__builtin_amdgcn_readfirstlane(vdst0 + (slotoff))); \
        if constexpr (C::NVD == 2) glds16(vb_, voff1, (unsigned)__builtin_amdgcn_readfirstlane(vdst1 + (slotoff))); } while (0)
    const lds_cptr kp0 = (lds_cptr)lds + C::LDS_K + hi * 1024 + r32 * 16;
    const lds_cptr vp0 = (lds_cptr)lds + C::LDS_V + ((lane >> 4) & 1) * 32 + (lane & 3) * 8 + (4 * hi + ((lane & 15) >> 2)) * 64;
    DMA_K(0, 0); DMA_K(1, C::KSLOT); DMA_K(2, 2 * C::KSLOT); DMA_V(0, 0);
    static_assert(C::NDMA == 3, "three LDS-DMA pieces per wave per tile");
    AT_WAITBAR(3);
    float l_reg = 0.f; f32x16 o[ND]; f32x16 pA0, pA1, pB0, pB1; u32x4 pw[4];
#pragma unroll
    for (int d = 0; d < ND; ++d) o[d] = f32x16{};
#pragma unroll
    for (int k = 0; k < 4; ++k) pw[k] = (u32x4){0u, 0u, 0u, 0u};
    int ks0 = 0, ks1 = C::KSLOT, ks2 = 2 * C::KSLOT, ks3 = 3 * C::KSLOT;
    s16x4 flo[(ND >= 4) ? 6 : 8], fhi[(ND >= 4) ? 6 : 8];
    int vsm = 2 * C::VSLOT, vs0 = 0, vs1 = C::VSLOT;
    (void)grp; (void)fixed_ref; (void)wsf;
    constexpr int NQK = 2 * NKS, NPV = 4 * ND, NOPS = NQK + NPV, WD = 6;
    constexpr int FA = (32 + NQK - 1) / NQK, FP = (16 + NQK - 1) / NQK, FE = 32 / NPV;
    static_assert(32 % NPV == 0, "exps split evenly over the P.V gaps");
#define PE(P0_, P1_, e_) (((e_) < 16) ? P0_[(e_) & 15] : P1_[(e_) & 15])
#define W_LOAD(i_) do { if ((i_) < NQK) { const bf16x8 kk_ = *(const LAS bf16x8*)(kp_ + ((i_) / 2) * 2048 + ((i_) % 2) * 512); flo[(i_) % WD] = (s16x4){kk_[0], kk_[1], kk_[2], kk_[3]}; fhi[(i_) % WD] = (s16x4){kk_[4], kk_[5], kk_[6], kk_[7]}; } \
        else { flo[(i_) % WD] = vtr(vp_ + (((i_) - NQK) / 4) * 4096 + (((i_) - NQK) % 4) * 1024); fhi[(i_) % WD] = vtr(vp_ + (((i_) - NQK) / 4) * 4096 + (((i_) - NQK) % 4) * 1024 + 512); } } while (0)
#define W_FRAG(i_) ((bf16x8){flo[(i_) % WD][0], flo[(i_) % WD][1], flo[(i_) % WD][2], flo[(i_) % WD][3], fhi[(i_) % WD][0], fhi[(i_) % WD][1], fhi[(i_) % WD][2], fhi[(i_) % WD][3]})
#define ISSUE_DMA(t_) do { if ((t_) + 3 < NT) DMA_K((t_) + 3, ks3); if ((t_) + 1 < NT) DMA_V((t_) + 1, vs1); } while (0)
#define PREFILL(t_) do { if ((t_) + 1 <= tmax) { const lds_cptr kn_ = kp0 + ks1; _Pragma("unroll") for (int i = 0; i < WD; ++i) { const bf16x8 kk_ = *(const LAS bf16x8*)(kn_ + (i / 2) * 2048 + (i % 2) * 512); flo[i] = (s16x4){kk_[0], kk_[1], kk_[2], kk_[3]}; fhi[i] = (s16x4){kk_[4], kk_[5], kk_[6], kk_[7]}; } } } while (0)
#define BIAS(C0_, C1_, t_) do { if constexpr (!MLA) { const int dmin_ = q0 + wid * 32 - 64 * (t_) - 63; \
        if (dmin_ < 559) { const LAS float* tb_ = (const LAS float*)(lds + C::LDS_BIAS) + (dmin_ + r32 + 126 - 4 * hi); \
            _Pragma("unroll") for (int r = 0; r < 16; ++r) { const int kk_ = (r & 3) + 8 * (r >> 2); C0_[r] += tb_[-kk_]; C1_[r] += tb_[-kk_ - 32]; } } } } while (0)
#define SUMPACK_ALL(P0_, P1_) do { float sa_ = 0.f; _Pragma("unroll") for (int e = 0; e < 32; ++e) sa_ += PE(P0_, P1_, e); l_reg += sa_; \
        _Pragma("unroll") for (int w = 0; w < 16; ++w) pw[w / 4][w % 4] = cvtpk(PE(P0_, P1_, 2 * w), PE(P0_, P1_, 2 * w + 1)); } while (0)
#define STEP(C0_, C1_, P0_, P1_, t_) do { \
        const lds_cptr kp_ = kp0 + ks0, vp_ = vp0 + vsm; \
        __builtin_amdgcn_sched_barrier(0); \
        float sacc_ = 0.f; \
        _Pragma("unroll") for (int g = 0; g < NQK; ++g) { const bf16x8 f_ = W_FRAG(g); \
            if ((g & 1) == 0) C0_ = (g / 2 == 0) ? __builtin_amdgcn_mfma_f32_32x32x16_bf16(f_, qr[0], (f32x16){}, 0, 0, 0) : __builtin_amdgcn_mfma_f32_32x32x16_bf16(f_, qr[g / 2], C0_, 0, 0, 0); \
            else C1_ = (g / 2 == 0) ? __builtin_amdgcn_mfma_f32_32x32x16_bf16(f_, qr[0], (f32x16){}, 0, 0, 0) : __builtin_amdgcn_mfma_f32_32x32x16_bf16(f_, qr[g / 2], C1_, 0, 0, 0); \
            if (g + WD < NOPS) W_LOAD(g + WD); \
            _Pragma("unroll") for (int j = 0; j < FA; ++j) { if (g * FA + j < 32) sacc_ += PE(P0_, P1_, (g * FA + j) & 31); } \
            _Pragma("unroll") for (int j = 0; j < FP; ++j) { if (g * FP + j < 16) { unsigned pk_ = cvtpk(PE(P0_, P1_, (2 * (g * FP + j)) & 31), PE(P0_, P1_, (2 * (g * FP + j) + 1) & 31)); asm volatile("" : "+v"(pk_)); pw[((g * FP + j) & 15) / 4][(g * FP + j) % 4] = pk_; } } \
            asm volatile("" : "+v"(sacc_)); \
            if (g == 1) { if ((t_) + 3 < NT) DMA_K((t_) + 3, ks3); } \
            if (g == 5) { if ((t_) + 1 < NT) DMA_V((t_) + 1, vs1); } \
            __builtin_amdgcn_sched_barrier(0); } \
        l_reg += sacc_; \
        BIAS(C0_, C1_, t_); \
        __builtin_amdgcn_sched_barrier(0); \
        _Pragma("unroll") for (int h = 0; h < NPV; ++h) { const bf16x8 f_ = W_FRAG(NQK + h); \
            o[h / 4] = __builtin_amdgcn_mfma_f32_32x32x16_bf16(__builtin_bit_cast(bf16x8, pw[h % 4]), f_, o[h / 4], 0, 0, 0); \
            if (NQK + h + WD < NOPS) W_LOAD(NQK + h + WD); \
            _Pragma("unroll") for (int j = 0; j < FE; ++j) { if (h * FE + j < 16) C0_[(h * FE + j) & 15] = __builtin_amdgcn_exp2f(C0_[(h * FE + j) & 15]); else C1_[(h * FE + j) & 15] = __builtin_amdgcn_exp2f(C1_[(h * FE + j) & 15]); } \
            if (h * FE < 16) asm volatile("" : "+v"(C0_)); else asm volatile("" : "+v"(C1_)); \
            __builtin_amdgcn_sched_barrier(0); } \
        PREFILL(t_); \
    } while (0)
#define DRAIN(P0_, P1_) do { SUMPACK_ALL(P0_, P1_); f32x16 d0_ = f32x16{}, d1_ = f32x16{}; const f32x16 z_ = f32x16{}; mfma_slot<NKS, ND, true, false>(o, d0_, d1_, pw, qr, z_, kp0 + ks0, vp0 + vsm); } while (0)
#define AT_CLOSE(t_) do { const int cnt_ = (((t_) + 3 < NT) ? C::NKD : 0) + (((t_) + 1 < NT) ? C::NVD : 0); \
        if (cnt_ == 3) { AT_WAITBAR_NL(3); } else if (cnt_ == 2) { AT_WAITBAR_NL(2); } else if (cnt_ == 1) { AT_WAITBAR_NL(1); } else { AT_WAITBAR_NL(0); } } while (0)
#define ROTATE() do { const int k_ = ks0; ks0 = ks1; ks1 = ks2; ks2 = ks3; ks3 = k_; const int v_ = vsm; vsm = vs0; vs0 = vs1; vs1 = v_; } while (0)
#define SLOT(C0_, C1_, P0_, P1_, t_) do { if ((t_) <= tmax) { STEP(C0_, C1_, P0_, P1_, t_); } else { ISSUE_DMA(t_); if ((t_) == tmax + 1) { DRAIN(P0_, P1_); } } AT_CLOSE(t_); ROTATE(); } while (0)
    { ISSUE_DMA(0);
      const f32x16 z_ = f32x16{};
      mfma_slot<NKS, ND, false, true>(o, pA0, pA1, pw, qr, z_, kp0 + ks0, vp0 + vsm);
      BIAS(pA0, pA1, 0);
#pragma unroll
      for (int r = 0; r < 16; ++r) { pA0[r] = __builtin_amdgcn_exp2f(pA0[r]); pA1[r] = __builtin_amdgcn_exp2f(pA1[r]); }
      PREFILL(0);
      AT_CLOSE(0); ROTATE(); }
    int t = 1; const int tlast = tmax < NT - 1 ? tmax : NT - 1;
#pragma unroll 1
    for (; t + 1 <= tlast; t += 2) {
        STEP(pB0, pB1, pA0, pA1, t); AT_CLOSE(t); ROTATE();
        STEP(pA0, pA1, pB0, pB1, t + 1); AT_CLOSE(t + 1); ROTATE();
    }
    if (t <= tlast) { STEP(pB0, pB1, pA0, pA1, t); AT_CLOSE(t); ROTATE(); pA0 = pB0; pA1 = pB1; ++t; }
    if (t < NT) { ISSUE_DMA(t); DRAIN(pA0, pA1); AT_CLOSE(t); ROTATE(); ++t; }
#pragma unroll 1
    for (; t < NT; ++t) { ISSUE_DMA(t); AT_CLOSE(t); ROTATE(); }
    if (tmax == NT - 1) { DRAIN(pA0, pA1); }
#undef PE
#undef W_LOAD
#undef W_FRAG
#undef ISSUE_DMA
#undef PREFILL
#undef BIAS
#undef SUMPACK_ALL
#undef STEP
#undef DRAIN
#undef ROTATE
#undef SLOT
    { auto rr = __builtin_amdgcn_permlane32_swap(__float_as_uint(l_reg), __float_as_uint(l_reg), false, false); l_reg = __uint_as_float(rr[0]) + __uint_as_float(rr[1]); }
    if (hi == 0) wsf[32 + r32] = l_reg;
    asm volatile("s_waitcnt lgkmcnt(0)" ::: "memory");
    { int le = lane; asm volatile("" : "+v"(le));
      const int r32e = le & 31, hie = le >> 5;
      LAS bf16_t* stg = (LAS bf16_t*)(lds + C::LDS_OST + wid * C::OSTW);
      constexpr int RW = ND * 32;
#pragma unroll
      for (int r = 0; r < 16; ++r) { const int orow = (r & 3) + 8 * (r >> 2); const float rl = __builtin_amdgcn_rcpf(wsf[32 + 4 * hie + orow]);
#pragma unroll
          for (int d0 = 0; d0 < ND; ++d0) { const unsigned w = cvtpk(o[d0][r] * rl, 0.f); stg[(4 * hie + r32e) + orow * RW + d0 * 32 + (RW - 1) * 4 * hie] = (bf16_t)(w & 0xffffu); } }
      asm volatile("s_waitcnt lgkmcnt(0)" ::: "memory");
      constexpr int CPR = ND * 4, RPI = 64 / CPR;
      const int rowl = le / CPR, ch = le % CPR;
      const LAS bf16_t* sp = stg + rowl * RW + ch * 8;
      bf16_t* Ow = P.O + (size_t)(P.rowbase + q0 + wid * 32 + rowl) * P.ldo + ch * 8;
      if (MLA || P.O1 == nullptr) {
#pragma unroll
          for (int i = 0; i < ND * 2; ++i) { const u32x4 v = *(const LAS u32x4*)(sp + i * RPI * RW); *(u32x4*)(Ow + (size_t)(i * RPI) * P.ldo) = v; }
      } else {
          const float lam = *P.lamp; const f32x4 g0 = *(const f32x4*)(P.gout + ch * 8) * 0.8f, g1 = *(const f32x4*)(P.gout + ch * 8 + 4) * 0.8f;
          const bf16_t* O1p = P.O1 + (size_t)(P.rowbase + q0 + wid * 32 + rowl) * 1024 + ch * 8; bf16_t* Yp = P.Yc + (size_t)(P.rowbase + q0 + wid * 32 + rowl) * 1024 + ch * 8;
#pragma unroll
          for (int i = 0; i < ND * 2; ++i) { const u32x4 v2 = *(const LAS u32x4*)(sp + i * RPI * RW); const u32x4 v1 = *(const u32x4*)(O1p + (size_t)(i * RPI) * 1024);
              f32x4 a = (f32x4){bflo(v1.x) - lam * bflo(v2.x), bfhi(v1.x) - lam * bfhi(v2.x), bflo(v1.y) - lam * bflo(v2.y), bfhi(v1.y) - lam * bfhi(v2.y)};
              f32x4 b = (f32x4){bflo(v1.z) - lam * bflo(v2.z), bfhi(v1.z) - lam * bfhi(v2.z), bflo(v1.w) - lam * bflo(v2.w), bfhi(v1.w) - lam * bfhi(v2.w)};
              float ss = sq4(a) + sq4(b); ss += __shfl_xor(ss, 1); ss += __shfl_xor(ss, 2); ss += __shfl_xor(ss, 4); ss += __shfl_xor(ss, 8);
              const float r = rsqrtf(ss * (1.0f / 128.0f) + EPS);
              *(u32x4*)(Yp + (size_t)(i * RPI) * 1024) = pack8(a * g0 * r, b * g1 * r); }
      } }
    AT_BAR();
#undef DMA_K
#undef DMA_V
#undef AT_CLOSE
}

template <int NKS, int ND, bool MLA>
__device__ __forceinline__ void attn_unit_iw2(const UnitP& P, LAS unsigned char* lds, const float* __restrict__ rope, const float* __restrict__ gq) {
    typedef Cfg<NKS, ND, 4> C;
    int tid = threadIdx.x; asm volatile("" : "+v"(tid));
    const int lane = tid & 63, r32 = lane & 31, hi = lane >> 5; const int wid = __builtin_amdgcn_readfirstlane(tid >> 6);
    const int grp = wid >> 2, q0 = P.qb * 256, NT = 4 * P.qb + 4, tmax = 4 * P.qb + (wid >> 1);
    bf16x8 qr[NKS];
    { const bf16_t* Qw = P.Q + (size_t)(P.rowbase + q0 + wid * 32 + r32) * P.ldq + hi * 8;
      if constexpr (MLA) {
        float qf[NKS][8]; float ss = 0.f;
#pragma unroll
        for (int d0 = 0; d0 < NKS; ++d0) { const bf16x8 raw = *(const bf16x8*)(Qw + d0 * 16);
#pragma unroll
            for (int j = 0; j < 8; ++j) { qf[d0][j] = bf2f(raw[j]); ss += qf[d0][j] * qf[d0][j]; } }
        ss += __shfl_xor(ss, 32);
        const float r = rsqrtf(ss * (1.0f / 96.0f) + EPS);
#pragma unroll
        for (int d0 = 0; d0 < NKS; ++d0) { const f32x4 g0 = *(const f32x4*)(gq + 16 * d0 + 8 * hi), g1 = *(const f32x4*)(gq + 16 * d0 + 8 * hi + 4);
#pragma unroll
            for (int j = 0; j < 4; ++j) { qf[d0][j] *= r * g0[j]; qf[d0][4 + j] *= r * g1[j]; } }
        const int pos = q0 + wid * 32 + r32; const float* rp = rope + (size_t)pos * 32 + 8 * hi;
        const f32x4 c0 = *(const f32x4*)rp, c1 = *(const f32x4*)(rp + 4), s0 = *(const f32x4*)(rp + 16), s1 = *(const f32x4*)(rp + 20);
#pragma unroll
        for (int j = 0; j < 8; ++j) { const float c = j < 4 ? c0[j & 3] : c1[j & 3], s = j < 4 ? s0[j & 3] : s1[j & 3]; const float a = qf[4][j], b = qf[5][j]; qf[4][j] = a * c - b * s; qf[5][j] = b * c + a * s; }
        const float sc = 0.10206207261596577f * LOG2E;
#pragma unroll
        for (int d0 = 0; d0 < NKS; ++d0) { u32x4 w; w.x = cvtpk(qf[d0][0] * sc, qf[d0][1] * sc); w.y = cvtpk(qf[d0][2] * sc, qf[d0][3] * sc); w.z = cvtpk(qf[d0][4] * sc, qf[d0][5] * sc); w.w = cvtpk(qf[d0][6] * sc, qf[d0][7] * sc);
            qr[d0] = __builtin_bit_cast(bf16x8, w); }
      } else {
#pragma unroll
        for (int d0 = 0; d0 < NKS; ++d0) qr[d0] = *(const bf16x8*)(Qw + d0 * 16);
      } }
    LAS float* wsf = (LAS float*)(lds + C::LDS_WS) + wid * 64;
    const bool fixed_ref = __builtin_amdgcn_readfirstlane(__float_as_int(*P.bound)) < __float_as_int(64.0f) && *P.bound >= 0.f;
    if constexpr (!MLA) { LAS float* tb = (LAS float*)(lds + C::LDS_BIAS); tb[tid] = P.btab[tid]; tb[tid + 512] = P.btab[tid + 512]; }
    asm volatile("s_waitcnt vmcnt(0)" ::: "memory");
    const unsigned lds0 = (unsigned)(size_t)lds;
    const bf16_t* kbase = P.K; const bf16_t* vbase = P.V;
    const unsigned koff0 = (unsigned)(wid * 1024 + lane * 16), koff1 = (unsigned)((8 + (wid & 3)) * 1024 + lane * 16);
    const unsigned kdst0 = lds0 + C::LDS_K + wid * 1024, kdst1 = lds0 + C::LDS_K + (8 + (wid & 3)) * 1024;
    const unsigned voff0 = (unsigned)(wid * 1024 + lane * 16), voff1 = voff0 + 8192u;
    const unsigned vdst0 = lds0 + C::LDS_V + wid * 1024, vdst1 = vdst0 + 8192;
    const size_t ktile = (size_t)C::KSLOT / 2, vtile = (size_t)C::VSLOT / 2;
#define DMA_K(t, slotoff) do { const bf16_t* kb_ = kbase + (size_t)(t) * ktile; glds16(kb_, koff0, (unsigned)__builtin_amdgcn_readfirstlane(kdst0 + (slotoff))); \
        if constexpr (C::NKD == 2) glds16(kb_, koff1, (unsigned)__builtin_amdgcn_readfirstlane(kdst1 + (slotoff))); } while (0)
#define DMA_V(t, slotoff) do { const bf16_t* vb_ = vbase + (size_t)(t) * vtile; glds16(vb_, voff0, (unsigned)__builtin_amdgcn_readfirstlane(vdst0 + (slotoff))); \
        if constexpr (C::NVD == 2) glds16(vb_, voff1, (unsigned)__builtin_amdgcn_readfirstlane(vdst1 + (slotoff))); } while (0)
    const lds_cptr kp0 = (lds_cptr)lds + C::LDS_K + hi * 1024 + r32 * 16;
    const lds_cptr vp0 = (lds_cptr)lds + C::LDS_V + ((lane >> 4) & 1) * 32 + (lane & 3) * 8 + (4 * hi + ((lane & 15) >> 2)) * 64;
    DMA_K(0, 0); DMA_K(1, C::KSLOT); DMA_K(2, 2 * C::KSLOT); DMA_V(0, 0);
    static_assert(C::NDMA == 3, "three LDS-DMA pieces per wave per tile");
    AT_WAITBAR(3);
    float l_reg = 0.f; f32x16 o[ND]; f32x16 c0, c1; u32x4 pwc[4], pwn[4];
#pragma unroll
    for (int d = 0; d < ND; ++d) o[d] = f32x16{};
#pragma unroll
    for (int k = 0; k < 4; ++k) { pwc[k] = (u32x4){0u, 0u, 0u, 0u}; pwn[k] = (u32x4){0u, 0u, 0u, 0u}; }
    int ks0 = 0, ks1 = C::KSLOT, ks2 = 2 * C::KSLOT, ks3 = 3 * C::KSLOT;
    s16x4 flo[(ND >= 4) ? 6 : 8], fhi[(ND >= 4) ? 6 : 8];
    int vsm = 2 * C::VSLOT, vs0 = 0, vs1 = C::VSLOT;
    (void)grp; (void)fixed_ref; (void)wsf;
    constexpr int NQK = 2 * NKS, NPV = 4 * ND, NOPS = NQK + NPV, WD = 6;
    static_assert(NPV == 16, "one bf16 pack word per P.V gap");
#define CE(e_) (((e_) < 16) ? c0[(e_) & 15] : c1[(e_) & 15])
#define W_LOAD(i_) do { if ((i_) < NQK) { const bf16x8 kk_ = *(const LAS bf16x8*)(kp_ + ((i_) / 2) * 2048 + ((i_) % 2) * 512); flo[(i_) % WD] = (s16x4){kk_[0], kk_[1], kk_[2], kk_[3]}; fhi[(i_) % WD] = (s16x4){kk_[4], kk_[5], kk_[6], kk_[7]}; } \
        else { flo[(i_) % WD] = vtr(vp_ + (((i_) - NQK) / 4) * 4096 + (((i_) - NQK) % 4) * 1024); fhi[(i_) % WD] = vtr(vp_ + (((i_) - NQK) / 4) * 4096 + (((i_) - NQK) % 4) * 1024 + 512); } } while (0)
#define W_FRAG(i_) ((bf16x8){flo[(i_) % WD][0], flo[(i_) % WD][1], flo[(i_) % WD][2], flo[(i_) % WD][3], fhi[(i_) % WD][0], fhi[(i_) % WD][1], fhi[(i_) % WD][2], fhi[(i_) % WD][3]})
#define ISSUE_DMA(t_) do { if ((t_) + 3 < NT) DMA_K((t_) + 3, ks3); if ((t_) + 1 < NT) DMA_V((t_) + 1, vs1); } while (0)
#define PREFILL(t_) do { if ((t_) + 1 <= tmax) { const lds_cptr kn_ = kp0 + ks1; _Pragma("unroll") for (int i = 0; i < WD; ++i) { const bf16x8 kk_ = *(const LAS bf16x8*)(kn_ + (i / 2) * 2048 + (i % 2) * 512); flo[i] = (s16x4){kk_[0], kk_[1], kk_[2], kk_[3]}; fhi[i] = (s16x4){kk_[4], kk_[5], kk_[6], kk_[7]}; } } } while (0)
#define BIAS(t_) do { if constexpr (!MLA) { const int dmin_ = q0 + wid * 32 - 64 * (t_) - 63; \
        if (dmin_ < 559) { const LAS float* tb_ = (const LAS float*)(lds + C::LDS_BIAS) + (dmin_ + r32 + 126 - 4 * hi); \
            _Pragma("unroll") for (int r = 0; r < 16; ++r) { const int kk_ = (r & 3) + 8 * (r >> 2); c0[r] += tb_[-kk_]; c1[r] += tb_[-kk_ - 32]; } } } } while (0)
#define EXPW(w_) do { if ((w_) < 8) { c0[(2 * (w_)) & 15] = __builtin_amdgcn_exp2f(c0[(2 * (w_)) & 15]); c0[(2 * (w_) + 1) & 15] = __builtin_amdgcn_exp2f(c0[(2 * (w_) + 1) & 15]); } \
        else { c1[(2 * (w_)) & 15] = __builtin_amdgcn_exp2f(c1[(2 * (w_)) & 15]); c1[(2 * (w_) + 1) & 15] = __builtin_amdgcn_exp2f(c1[(2 * (w_) + 1) & 15]); } } while (0)
#define PACKW(PWN_, w_) do { const float a_ = CE(2 * (w_)), b_ = CE(2 * (w_) + 1); sacc_ += a_ + b_; PWN_[(w_) / 4][(w_) % 4] = cvtpk(a_, b_); } while (0)
#define STEP(t_, PWC_, PWN_) do { \
        const lds_cptr kp_ = kp0 + ks0, vp_ = vp0 + vsm; \
        __builtin_amdgcn_sched_barrier(0); \
        _Pragma("unroll") for (int g = 0; g < NQK; ++g) { const bf16x8 f_ = W_FRAG(g); \
            if ((g & 1) == 0) c0 = (g / 2 == 0) ? __builtin_amdgcn_mfma_f32_32x32x16_bf16(f_, qr[0], (f32x16){}, 0, 0, 0) : __builtin_amdgcn_mfma_f32_32x32x16_bf16(f_, qr[g / 2], c0, 0, 0, 0); \
            else c1 = (g / 2 == 0) ? __builtin_amdgcn_mfma_f32_32x32x16_bf16(f_, qr[0], (f32x16){}, 0, 0, 0) : __builtin_amdgcn_mfma_f32_32x32x16_bf16(f_, qr[g / 2], c1, 0, 0, 0); \
            if (g + WD < NOPS) W_LOAD(g + WD); \
            if (g == 1) { if ((t_) + 3 < NT) DMA_K((t_) + 3, ks3); } \
            if (g == 3) { if ((t_) + 1 < NT) DMA_V((t_) + 1, vs1); } \
            __builtin_amdgcn_sched_barrier(0); } \
        BIAS(t_); \
        __builtin_amdgcn_sched_barrier(0); \
        float sacc_ = 0.f; \
        _Pragma("unroll") for (int h = 0; h < NPV; ++h) { const bf16x8 f_ = W_FRAG(NQK + h); \
            o[h / 4] = __builtin_amdgcn_mfma_f32_32x32x16_bf16(__builtin_bit_cast(bf16x8, PWC_[h % 4]), f_, o[h / 4], 0, 0, 0); \
            if (NQK + h + WD < NOPS) W_LOAD(NQK + h + WD); \
            EXPW(h); if (h >= 1) PACKW(PWN_, h - 1); \
            asm volatile("" : "+v"(sacc_)); \
            __builtin_amdgcn_sched_barrier(0); } \
        PACKW(PWN_, 15); l_reg += sacc_; \
        PREFILL(t_); \
    } while (0)
#define DRAIN() do { f32x16 d0_ = f32x16{}, d1_ = f32x16{}; const f32x16 z_ = f32x16{}; mfma_slot<NKS, ND, true, false>(o, d0_, d1_, pwc, qr, z_, kp0 + ks0, vp0 + vsm); } while (0)
#define AT_CLOSE(t_) do { const int cnt_ = (((t_) + 3 < NT) ? C::NKD : 0) + (((t_) + 1 < NT) ? C::NVD : 0); \
        if (cnt_ == 3) { AT_WAITBAR_NL(3); } else if (cnt_ == 2) { AT_WAITBAR_NL(2); } else if (cnt_ == 1) { AT_WAITBAR_NL(1); } else { AT_WAITBAR_NL(0); } } while (0)
#define ROTATE() do { const int k_ = ks0; ks0 = ks1; ks1 = ks2; ks2 = ks3; ks3 = k_; const int v_ = vsm; vsm = vs0; vs0 = vs1; vs1 = v_; } while (0)
#define PW_ADVANCE() do { _Pragma("unroll") for (int k = 0; k < 4; ++k) pwc[k] = pwn[k]; } while (0)
    { ISSUE_DMA(0);
      const f32x16 z_ = f32x16{};
      mfma_slot<NKS, ND, false, true>(o, c0, c1, pwc, qr, z_, kp0 + ks0, vp0 + vsm);
      BIAS(0);
      float sacc_ = 0.f;
#pragma unroll
      for (int w = 0; w < 16; ++w) { EXPW(w); PACKW(pwc, w); }
      l_reg += sacc_;
      PREFILL(0);
      AT_CLOSE(0); ROTATE(); }
    int t = 1; const int tlast = tmax < NT - 1 ? tmax : NT - 1;
#pragma unroll 1
    for (; t + 1 <= tlast; t += 2) {
        STEP(t, pwc, pwn); AT_CLOSE(t); ROTATE();
        STEP(t + 1, pwn, pwc); AT_CLOSE(t + 1); ROTATE();
    }
    if (t <= tlast) { STEP(t, pwc, pwn); PW_ADVANCE(); AT_CLOSE(t); ROTATE(); ++t; }
    if (t < NT) { ISSUE_DMA(t); DRAIN(); AT_CLOSE(t); ROTATE(); ++t; }
#pragma unroll 1
    for (; t < NT; ++t) { ISSUE_DMA(t); AT_CLOSE(t); ROTATE(); }
    if (tmax == NT - 1) { DRAIN(); }
#undef CE
#undef W_LOAD
#undef W_FRAG
#undef ISSUE_DMA
#undef PREFILL
#undef BIAS
#undef EXPW
#undef PACKW
#undef STEP
#undef DRAIN
#undef ROTATE
#undef PW_ADVANCE
    { auto rr = __builtin_amdgcn_permlane32_swap(__float_as_uint(l_reg), __float_as_uint(l_reg), false, false); l_reg = __uint_as_float(rr[0]) + __uint_as_float(rr[1]); }
    if (hi == 0) wsf[32 + r32] = l_reg;
    asm volatile("s_waitcnt lgkmcnt(0)" ::: "memory");
    { int le = lane; asm volatile("" : "+v"(le));
      const int r32e = le & 31, hie = le >> 5;
      LAS bf16_t* stg = (LAS bf16_t*)(lds + C::LDS_OST + wid * C::OSTW);
      constexpr int RW = ND * 32;
#pragma unroll
      for (int r = 0; r < 16; ++r) { const int orow = (r & 3) + 8 * (r >> 2); const float rl = __builtin_amdgcn_rcpf(wsf[32 + 4 * hie + orow]);
#pragma unroll
          for (int d0 = 0; d0 < ND; ++d0) { const unsigned w = cvtpk(o[d0][r] * rl, 0.f); stg[(4 * hie + r32e) + orow * RW + d0 * 32 + (RW - 1) * 4 * hie] = (bf16_t)(w & 0xffffu); } }
      asm volatile("s_waitcnt lgkmcnt(0)" ::: "memory");
      constexpr int CPR = ND * 4, RPI = 64 / CPR;
      const int rowl = le / CPR, ch = le % CPR;
      const LAS bf16_t* sp = stg + rowl * RW + ch * 8;
      bf16_t* Ow = P.O + (size_t)(P.rowbase + q0 + wid * 32 + rowl) * P.ldo + ch * 8;
      if (MLA || P.O1 == nullptr) {
#pragma unroll
          for (int i = 0; i < ND * 2; ++i) { const u32x4 v = *(const LAS u32x4*)(sp + i * RPI * RW); *(u32x4*)(Ow + (size_t)(i * RPI) * P.ldo) = v; }
      } else {
          const float lam = *P.lamp; const f32x4 g0 = *(const f32x4*)(P.gout + ch * 8) * 0.8f, g1 = *(const f32x4*)(P.gout + ch * 8 + 4) * 0.8f;
          const bf16_t* O1p = P.O1 + (size_t)(P.rowbase + q0 + wid * 32 + rowl) * 1024 + ch * 8; bf16_t* Yp = P.Yc + (size_t)(P.rowbase + q0 + wid * 32 + rowl) * 1024 + ch * 8;
#pragma unroll
          for (int i = 0; i < ND * 2; ++i) { const u32x4 v2 = *(const LAS u32x4*)(sp + i * RPI * RW); const u32x4 v1 = *(const u32x4*)(O1p + (size_t)(i * RPI) * 1024);
              f32x4 a = (f32x4){bflo(v1.x) - lam * bflo(v2.x), bfhi(v1.x) - lam * bfhi(v2.x), bflo(v1.y) - lam * bflo(v2.y), bfhi(v1.y) - lam * bfhi(v2.y)};
              f32x4 b = (f32x4){bflo(v1.z) - lam * bflo(v2.z), bfhi(v1.z) - lam * bfhi(v2.z), bflo(v1.w) - lam * bflo(v2.w), bfhi(v1.w) - lam * bfhi(v2.w)};
              float ss = sq4(a) + sq4(b); ss += __shfl_xor(ss, 1); ss += __shfl_xor(ss, 2); ss += __shfl_xor(ss, 4); ss += __shfl_xor(ss, 8);
              const float r = rsqrtf(ss * (1.0f / 128.0f) + EPS);
              *(u32x4*)(Yp + (size_t)(i * RPI) * 1024) = pack8(a * g0 * r, b * g1 * r); }
      } }
    AT_BAR();
#undef DMA_K
#undef DMA_V
#undef AT_CLOSE
}
}

constexpr int NWAVES = 8;
#ifndef IW_MLA
#define IW_MLA 1
#endif
#ifndef IW_DIFF
#define IW_DIFF 1
#endif
constexpr int N_PHASES = 10;
#ifndef MK_N_LAUNCHES
#define MK_N_LAUNCHES 1
#endif
constexpr size_t MiB = 1u << 20;
constexpr size_t WS_CTL = 0, CTL_ZERO_BYTES = 64 * 1024;
constexpr size_t WS_WIN = 1 * MiB;
constexpr size_t WS_WUP = 5 * MiB;
constexpr size_t WS_WOUT = 7 * MiB;
constexpr size_t WS_WG = 9 * MiB;
constexpr size_t WS_WU = 15 * MiB;
constexpr size_t WS_WD = 21 * MiB;
constexpr size_t WS_WPG = 27 * MiB;
constexpr size_t WS_WPP = 29 * MiB;
constexpr size_t WS_ROPE = 30 * MiB;
constexpr size_t WS_BTAB = 31 * MiB;
constexpr size_t WS_SSQ = 32 * MiB;
constexpr size_t WS_SSKV = 33 * MiB;
constexpr size_t WS_KRSS = 34 * MiB;
constexpr size_t WS_KRR = 35 * MiB;
constexpr size_t WS_SS1 = 40 * MiB;
constexpr size_t WS_SS2 = 43 * MiB;
constexpr size_t WS_PB = 48 * MiB;
constexpr size_t WS_XN = 64 * MiB;
constexpr size_t WS_Z = 128 * MiB;
constexpr size_t WS_DKI = 192 * MiB;
constexpr size_t WS_DVI = 224 * MiB;
constexpr size_t WS_QR = 256 * MiB;
constexpr size_t WS_KM = 304 * MiB;
constexpr size_t WS_VM = 352 * MiB;
constexpr size_t WS_Y = 384 * MiB;
constexpr size_t WS_OD = 448 * MiB;
constexpr size_t WS_X1B = WS_XN;
constexpr size_t WS_G = 128 * MiB;
constexpr size_t WS_ACT = 304 * MiB;
constexpr size_t WS_X2B = 128 * MiB;
constexpr size_t WS_PR = 64 * MiB;
constexpr size_t WS_END = 512 * MiB;
constexpr int CW_BAR = 1024;
constexpr int RING_BYTES = 131072, LDS_BYTES = 155648, MISC_OFF = LDS_BYTES - 256;
static_assert(attn::Cfg<4, 4, 4>::LDS_END <= MISC_OFF && attn::Cfg<6, 2, 4>::LDS_END <= MISC_OFF && MISC_OFF + 256 <= 160 * 1024, "attention LDS map");

typedef GAS unsigned gu32;
#define VM_WAIT() asm volatile("s_waitcnt vmcnt(0)" ::: "memory")
#define LDS_WAIT() asm volatile("s_waitcnt lgkmcnt(0)" ::: "memory")

#define XB_TMO      128
#define XB_XCNT(j)  (256  + 64 * (j))
#define XB_XSUB(j)  (1280 + 64 * (j))
#define XB_XGEN(j)  (2304 + 64 * (j))
#define XB_TOP      3328
#define XB_TOPGEN   3392
#define XCD_BAR_WORDS 3456
#define XB_SPIN_CAP (1u << 18)
__device__ __forceinline__ unsigned xb_ld(unsigned* p)              { return __hip_atomic_load(p, __ATOMIC_RELAXED, __HIP_MEMORY_SCOPE_AGENT); }
__device__ __forceinline__ unsigned xb_add(unsigned* p, unsigned v) { return __hip_atomic_fetch_add(p, v, __ATOMIC_RELAXED, __HIP_MEMORY_SCOPE_AGENT); }
__device__ __forceinline__ unsigned xb_xcc_id() { return (unsigned)__builtin_amdgcn_s_getreg((3 << 11) | 20) & 0xFu; }
#define XB_SPIN(cond, bar) do { unsigned _sp = 0; while (cond) { __builtin_amdgcn_s_sleep(1); \
    if ((++_sp & 255u) == 0u) { if (xb_ld(&(bar)[XB_TMO])) break; if (_sp > XB_SPIN_CAP) { atomicAdd(&(bar)[XB_TMO], 1u); break; } } } } while (0)
struct XcdBarrier { unsigned* bar; unsigned x; volatile LAS unsigned* st; };
__device__ __forceinline__ XcdBarrier xcd_barrier_post(unsigned* bar, volatile LAS unsigned* st) {
    XcdBarrier b; b.bar = bar; b.x = xb_xcc_id(); b.st = st;
    if (threadIdx.x == 0) (void)xb_add(&bar[XB_XCNT(b.x)], 1u);
    return b;
}
__device__ __forceinline__ void xcd_barrier_complete(unsigned* bar, unsigned x, unsigned& nloc, unsigned& nx) {
    const unsigned G = gridDim.x * gridDim.y * gridDim.z;
    unsigned sum, cnt, mine, sp = 0u;
    for (;;) {
        sum = 0u; cnt = 0u; mine = 0u;
#pragma unroll
        for (unsigned j = 0; j < 16; ++j) { const unsigned c = xb_ld(&bar[XB_XCNT(j)]); sum += c; cnt += (c > 0u) ? 1u : 0u; mine = (j == x) ? c : mine; }
        if (sum == G) break;
        __builtin_amdgcn_s_sleep(1);
        if ((++sp & 255u) == 0u) { if (xb_ld(&bar[XB_TMO])) break; if (sp > XB_SPIN_CAP) { atomicAdd(&bar[XB_TMO], 1u); break; } }
    }
    nloc = mine > 0u ? mine : 1u; nx = cnt > 0u ? cnt : 1u;
}
__device__ __forceinline__ void xcd_barrier(const XcdBarrier& b) {
    asm volatile("s_waitcnt vmcnt(0)" ::: "memory");
    __syncthreads();
    if (threadIdx.x == 0) {
        unsigned* bar = b.bar;
        __builtin_amdgcn_s_waitcnt(0);
        unsigned nloc = b.st[0], nx = b.st[1];
        if (nloc == 0u) { xcd_barrier_complete(bar, b.x, nloc, nx); b.st[0] = nloc; b.st[1] = nx; }
        const unsigned old = xb_add(&bar[XB_XSUB(b.x)], 1u);
        const unsigned gen = old / nloc;
        if (old + 1u == (gen + 1u) * nloc) {
            __builtin_amdgcn_fence(__ATOMIC_RELEASE, "agent");
            asm volatile("s_waitcnt vmcnt(0)" ::: "memory");
            const unsigned og = xb_add(&bar[XB_TOP], 1u);
            const unsigned tg = og / nx;
            if (og + 1u == (tg + 1u) * nx) xb_add(&bar[XB_TOPGEN], 1u);
            else XB_SPIN(xb_ld(&bar[XB_TOPGEN]) == tg, bar);
            __builtin_amdgcn_fence(__ATOMIC_ACQUIRE, "agent");
            xb_add(&bar[XB_XGEN(b.x)], 1u);
            asm volatile("s_waitcnt vmcnt(0)" ::: "memory");
        } else {
            XB_SPIN(xb_ld(&bar[XB_XGEN(b.x)]) == gen, bar);
            __builtin_amdgcn_fence(__ATOMIC_ACQUIRE, "agent");
            asm volatile("s_waitcnt vmcnt(0)" ::: "memory");
        }
    }
    __syncthreads();
}

struct Args { const float* in[28]; float* out; unsigned char* ws; int ph_lo, ph_hi; };

__device__ __forceinline__ float wave_sum(float v) {
#pragma unroll
    for (int o = 1; o < 64; o <<= 1) v += __shfl_xor(v, o);
    return v;
}
__device__ __forceinline__ int t5_bucket(int rel) {
    const int nb = 16, max_exact = 8;
    const int sign_off = rel > 0 ? nb : 0;
    const int n = rel < 0 ? -rel : rel;
    const float nf = (float)(n > 1 ? n : 1);
    int large = max_exact + (int)(logf(nf / 8.0f) / 4.852030263919617f * 8.0f);
    large = large < nb - 1 ? large : nb - 1;
    return sign_off + (n < max_exact ? n : large);
}

__device__ __forceinline__ void wt_item(const float* W, int ldw, int srccol0, int srck0, const float* gain, bf16_t* WT, int ldk, int dstrow0, int dstk0, LAS float* scr, int lane) {
    const int c = lane & 7;
    if (W == nullptr) {
#pragma unroll
        for (int j = 0; j < 4; ++j) { const int n = (lane >> 3) + 8 * j; *(GAS u32x4*)(WT + (size_t)(dstrow0 + n) * ldk + dstk0 + 8 * c) = (u32x4){0u, 0u, 0u, 0u}; }
        return;
    }
    float wv[32];
#pragma unroll
    for (int i = 0; i < 32; ++i) { const int kk = 2 * i + (lane >> 5); wv[i] = W[(size_t)(srck0 + kk) * ldw + srccol0 + (lane & 31)]; }
    if (gain) {
#pragma unroll
        for (int i = 0; i < 32; ++i) wv[i] *= gain[srck0 + 2 * i + (lane >> 5)];
    }
#pragma unroll
    for (int i = 0; i < 32; ++i) scr[(2 * i + (lane >> 5)) * 33 + (lane & 31)] = wv[i];
    LDS_WAIT(); asm volatile("" ::: "memory");
#pragma unroll
    for (int j = 0; j < 4; ++j) { const int n = (lane >> 3) + 8 * j; const LAS float* s = scr + (8 * c) * 33 + n;
        u32x4 o; o.x = cvtpk(s[0 * 33], s[1 * 33]); o.y = cvtpk(s[2 * 33], s[3 * 33]); o.z = cvtpk(s[4 * 33], s[5 * 33]); o.w = cvtpk(s[6 * 33], s[7 * 33]);
        *(GAS u32x4*)(WT + (size_t)(dstrow0 + n) * ldk + dstk0 + 8 * c) = o; }
    LDS_WAIT(); asm volatile("" ::: "memory");
}

__device__ __forceinline__ int win_src_col(int b32) {
    const int pn = b32 >> 3, q = b32 & 7, bj = q >> 2, wc = q & 3;
    if (pn == 0) return OFF_Q_LAT + 32 * q;
    if (pn == 1) return bj == 0 ? OFF_KV_LAT + 32 * wc : (wc == 0 ? OFF_K_ROPE : -1);
    if (pn < 4) return OFF_DIFF_Q + 64 * (4 * (pn - 2) + wc) + 32 * bj;
    if (pn < 6) return OFF_DIFF_K + 64 * (4 * (pn - 4) + wc) + 32 * bj;
    return OFF_DIFF_V + 256 * (pn - 6) + 32 * q;
}


typedef const __attribute__((address_space(4))) Args* KArgs;
#define PHASE_PTRS() \
    KArgs ap = (KArgs)__builtin_amdgcn_kernarg_segment_ptr(); asm volatile("" : "+s"(ap)); \
    unsigned char* const ws = ap->ws; float* const out = ap->out; (void)out; \
    const float* const x = ap->in[0]; const float* const p_in = ap->in[1]; const float* const attn_norm_g = ap->in[2]; const float* const w_in = ap->in[3]; \
    const float* const q_lat_norm_g = ap->in[4]; const float* const w_uq = ap->in[5]; const float* const kv_lat_norm_g = ap->in[6]; const float* const w_ukv = ap->in[7]; \
    const float* const mla_q_norm_g = ap->in[8]; const float* const mla_k_norm_g = ap->in[9]; const float* const diff_q_norm_g = ap->in[10]; const float* const diff_k_norm_g = ap->in[11]; \
    const float* const lq1 = ap->in[12]; const float* const lk1 = ap->in[13]; const float* const lq2 = ap->in[14]; const float* const lk2 = ap->in[15]; \
    const float* const diff_out_norm_g = ap->in[16]; const float* const rel_bias = ap->in[17]; const float* const w_out = ap->in[18]; const float* const ffn_norm_g = ap->in[19]; \
    const float* const w_gate = ap->in[20]; const float* const w_up = ap->in[21]; const float* const conv_w = ap->in[22]; const float* const conv_b = ap->in[23]; const float* const w_down = ap->in[24]; \
    const float* const ple_norm_g = ap->in[25]; const float* const w_ple_gate = ap->in[26]; const float* const w_ple_proj = ap->in[27]; \
    bf16_t* const WIN = (bf16_t*)(ws + WS_WIN); bf16_t* const WUP = (bf16_t*)(ws + WS_WUP); bf16_t* const WUKV = (bf16_t*)(ws + WS_WUP + 512 * 1024); bf16_t* const WOUT = (bf16_t*)(ws + WS_WOUT); bf16_t* const WG = (bf16_t*)(ws + WS_WG); \
    bf16_t* const WU = (bf16_t*)(ws + WS_WU); bf16_t* const WD = (bf16_t*)(ws + WS_WD); bf16_t* const WPG = (bf16_t*)(ws + WS_WPG); bf16_t* const WPP = (bf16_t*)(ws + WS_WPP); \
    float* const ROPE = (float*)(ws + WS_ROPE); float* const BTAB = (float*)(ws + WS_BTAB); \
    float* const SSQ = (float*)(ws + WS_SSQ); float* const SSKV = (float*)(ws + WS_SSKV); float* const KRSS = (float*)(ws + WS_KRSS); float* const KRR = (float*)(ws + WS_KRR); \
    float* const SS1 = (float*)(ws + WS_SS1); float* const SS2 = (float*)(ws + WS_SS2); \
    bf16_t* const PB = (bf16_t*)(ws + WS_PB); bf16_t* const XN = (bf16_t*)(ws + WS_XN); bf16_t* const Z = (bf16_t*)(ws + WS_Z); bf16_t* const QR = (bf16_t*)(ws + WS_QR); \
    bf16_t* const KM = (bf16_t*)(ws + WS_KM); bf16_t* const VM = (bf16_t*)(ws + WS_VM); bf16_t* const DKI = (bf16_t*)(ws + WS_DKI); bf16_t* const DVI = (bf16_t*)(ws + WS_DVI); bf16_t* const Y = (bf16_t*)(ws + WS_Y); bf16_t* const OD = (bf16_t*)(ws + WS_OD); \
    bf16_t* const X1B = (bf16_t*)out; bf16_t* const GT = (bf16_t*)(ws + WS_G); bf16_t* const ACT = (bf16_t*)(ws + WS_ACT); bf16_t* const X2B = (bf16_t*)(ws + WS_X2B); bf16_t* const PRB = (bf16_t*)(ws + WS_PR); \
    (void)x; (void)p_in; (void)attn_norm_g; (void)w_in; (void)q_lat_norm_g; (void)w_uq; (void)kv_lat_norm_g; (void)w_ukv; (void)mla_q_norm_g; (void)mla_k_norm_g; (void)diff_q_norm_g; (void)diff_k_norm_g; \
    (void)lq1; (void)lk1; (void)lq2; (void)lk2; (void)diff_out_norm_g; (void)rel_bias; (void)w_out; (void)ffn_norm_g; (void)w_gate; (void)w_up; (void)conv_w; (void)conv_b; (void)w_down; (void)ple_norm_g; (void)w_ple_gate; (void)w_ple_proj; \
    (void)WIN; (void)WUP; (void)WUKV; (void)WOUT; (void)WG; (void)WU; (void)WD; (void)WPG; (void)WPP; (void)ROPE; (void)BTAB; (void)SSQ; (void)SSKV; (void)KRSS; (void)KRR; (void)SS1; (void)SS2; (void)PB; (void)XN; (void)Z; (void)QR; (void)KM; (void)VM; (void)DKI; (void)DVI; (void)Y; (void)OD; (void)X1B; (void)GT; (void)ACT; (void)X2B; (void)PRB

__global__ void __launch_bounds__(NWAVES * 64, 2) mk_fwd(Args args) {
    extern __shared__ __attribute__((aligned(16))) unsigned char lds_raw[];
    LAS unsigned char* lds = (LAS unsigned char*)lds_raw;
    volatile LAS unsigned* MISC = (volatile LAS unsigned*)(lds + MISC_OFF);
    const int tid = threadIdx.x, lane = tid & 63, wave = __builtin_amdgcn_readfirstlane(tid >> 6);
    const int G = gridDim.x, bx = blockIdx.x;
    const int vcu = (G % 8 == 0) ? (bx % 8) * (G / 8) + bx / 8 : bx;
    gu32* ctl = (gu32*)(args.ws + WS_CTL);
    if (tid < 64) MISC[tid] = 0u;
    __syncthreads();
    XcdBarrier bar = xcd_barrier_post((unsigned*)ctl + CW_BAR, MISC + 8);
    const int lo = args.ph_lo, hi_ph = args.ph_hi;
#ifndef PH_MASK
#define PH_MASK 0x3ff
#endif
#define IN(k) (((PH_MASK >> (k)) & 1) && lo <= (k) && (k) < hi_ph)
#define BOTH(k) (IN(k) && IN((k) + 1))
#ifndef REP_MASK
#define REP_MASK 0
#endif
#define NREP(k) (1 + ((REP_MASK >> (k)) & 1))
#define GRID_BAR() xcd_barrier(bar)
    const int gw = vcu * NWAVES + wave, NGW = G * NWAVES;

    if (IN(0)) {
        PHASE_PTRS();
        LAS float* scr = (LAS float*)(lds + wave * 16384);
        constexpr int I_IN = 64 * 16, I_UQ = 24 * 4, I_UKV = 32 * 2, I_OUT = 32 * 16, I_G = 88 * 16, I_U = 88 * 16, I_D = 32 * 44, I_PG = 32 * 16, I_PP = 32 * 4;
        constexpr int NITEMS = I_IN + I_UQ + I_UKV + I_OUT + I_G + I_U + I_PP;
        (void)I_D; (void)I_PG;
        for (int it = gw; it < NITEMS; it += NGW) {
            int r = it;
            if (r < I_IN) { const int nb = r / 16, kb = r % 16; const int sc = win_src_col(nb);
                wt_item(sc < 0 ? nullptr : w_in, IN_COLS, sc, 64 * kb, attn_norm_g, WIN, 1024, 32 * nb, 64 * kb, scr, lane); continue; } r -= I_IN;
            if (r < I_UQ) { wt_item(w_uq, 768, 32 * (r / 4), 64 * (r % 4), q_lat_norm_g, WUP, 256, 32 * (r / 4), 64 * (r % 4), scr, lane); continue; } r -= I_UQ;
            if (r < I_UKV) { const int nb = r / 2, kb = r % 2; const int pn = nb >> 3, q = nb & 7, bj = q >> 2, wc = q & 3;
                int sc; if (pn < 2) sc = 128 * (4 * pn + wc) + 32 * bj; else { const int p0 = 256 * (pn - 2) + 32 * q; sc = 128 * (p0 / 64) + 64 + (p0 % 64); }
                wt_item(w_ukv, 1024, sc, 64 * kb, kv_lat_norm_g, WUKV, 128, 32 * nb, 64 * kb, scr, lane); continue; } r -= I_UKV;
            if (r < I_OUT) { wt_item(w_out, 1024, 32 * (r / 16), 64 * (r % 16), nullptr, WOUT, 1024, 32 * (r / 16), 64 * (r % 16), scr, lane); continue; } r -= I_OUT;
            if (r < I_G) { wt_item(w_gate, D_FF, 32 * (r / 16), 64 * (r % 16), ffn_norm_g, WG, 1024, 32 * (r / 16), 64 * (r % 16), scr, lane); continue; } r -= I_G;
            if (r < I_U) { wt_item(w_up, D_FF, 32 * (r / 16), 64 * (r % 16), ffn_norm_g, WU, 1024, 32 * (r / 16), 64 * (r % 16), scr, lane); continue; } r -= I_U;
            wt_item(w_ple_proj, 1024, 32 * (r / 4), 64 * (r % 4), nullptr, WPP, 256, 32 * (r / 4), 64 * (r % 4), scr, lane);
        }
        for (int m0 = gw * 4; m0 < T_TOK; m0 += NGW * 4) {
            f32x4 v[4][4]; float s[4];
#pragma unroll
            for (int q = 0; q < 4; ++q) { const GAS f32x4* xr = (const GAS f32x4*)(x + (size_t)(m0 + q) * D_MODEL) + lane;
#pragma unroll
                for (int j = 0; j < 4; ++j) v[q][j] = xr[64 * j]; }
#pragma unroll
            for (int q = 0; q < 4; ++q) { s[q] = 0.f;
#pragma unroll
                for (int j = 0; j < 4; ++j) s[q] += sq4(v[q][j]); }
#pragma unroll
            for (int q = 0; q < 4; ++q) { const float r = rsqrtf(wave_sum(s[q]) * (1.0f / D_MODEL) + EPS);
                GAS u32x2* o8 = (GAS u32x2*)(XN + (size_t)(m0 + q) * D_MODEL) + lane;
#pragma unroll
                for (int j = 0; j < 4; ++j) o8[64 * j] = (u32x2){cvtpk(v[q][j][0] * r, v[q][j][1] * r), cvtpk(v[q][j][2] * r, v[q][j][3] * r)}; }
        }
        { const size_t n8 = ((T_TOK / 256) * (D_FF / 256) % G == 0) ? (size_t)T_TOK * PLE_DIM / 8 : 0;
          const size_t gt = (size_t)vcu * (NWAVES * 64) + tid, NGT = (size_t)G * NWAVES * 64;
          for (size_t i = gt; i < n8; i += 4 * NGT) { f32x4 a[4], b[4];
#pragma unroll
              for (int q = 0; q < 4; ++q) { const size_t ii = i + q * NGT; if (ii < n8) { a[q] = *(const GAS f32x4*)(p_in + ii * 8); b[q] = *(const GAS f32x4*)(p_in + ii * 8 + 4); } }
#pragma unroll
              for (int q = 0; q < 4; ++q) { const size_t ii = i + q * NGT; if (ii < n8) *(GAS u32x4*)(PB + ii * 8) = pack8(a[q], b[q]); } }
          for (size_t i = gt; i < (size_t)SEQ * 16; i += NGT) { const int pos = (int)(i >> 4), k = (int)(i & 15); const float inv = powf(10000.0f, -(float)k / 16.0f); const float ang = (float)pos * inv;
              ROPE[(size_t)pos * 32 + k] = cosf(ang); ROPE[(size_t)pos * 32 + 16 + k] = sinf(ang); }
          for (size_t i = gt; i < 4096; i += NGT) { const int h = (int)(i >> 10), k = (int)(i & 1023); BTAB[i] = (rel_bias[t5_bucket(63 - k) * 4 + h] - rel_bias[15 * 4 + h]) * LOG2E; }
          if (gw == 0) {
              const float s1 = wave_sum(lq1[lane] * lk1[lane]), s2 = wave_sum(lq2[lane] * lk2[lane]);
              float mq = fmaxf(fabsf(mla_q_norm_g[lane]), lane < 32 ? fabsf(mla_q_norm_g[64 + lane]) : 0.f), mk = fmaxf(fabsf(mla_k_norm_g[lane]), lane < 32 ? fabsf(mla_k_norm_g[64 + lane]) : 0.f);
              float dq = fabsf(diff_q_norm_g[lane]), dk = fabsf(diff_k_norm_g[lane]), mb = fmaxf(fabsf(rel_bias[lane]), fabsf(rel_bias[64 + lane]));
#pragma unroll
              for (int o = 1; o < 64; o <<= 1) { mq = fmaxf(mq, __shfl_xor(mq, o)); mk = fmaxf(mk, __shfl_xor(mk, o)); dq = fmaxf(dq, __shfl_xor(dq, o)); dk = fmaxf(dk, __shfl_xor(dk, o)); mb = fmaxf(mb, __shfl_xor(mb, o)); }
              if (lane == 0) { BTAB[4096] = expf(s1) - expf(s2) + 0.2f;
                  BTAB[4097] = 96.0f * mq * mk * 0.10206207261596577f * LOG2E;
                  BTAB[4098] = 64.0f * dq * dk * 0.125f * LOG2E + 2.0f * mb * LOG2E; } }
        }
        if (BOTH(0)) GRID_BAR();
    }
    if (IN(1)) for (int rep_ = 0; rep_ < NREP(1); ++rep_) {
        PHASE_PTRS();
        pg8::Gemm g{XN, WIN, T_TOK, 2048, 1024, 1024}; pg8::StaticOrder S; S.init(T_TOK, 2048, G, bx);
        EpiIn E{Z, DKI, DVI, SSQ, SSKV, KRR, KRSS, ROPE, diff_q_norm_g, diff_k_norm_g, mla_k_norm_g};
        pg8::gemm_phase(lds, g, S, E);
        if (BOTH(1)) GRID_BAR();
    }
    if (IN(2)) for (int rep_ = 0; rep_ < NREP(2); ++rep_) {
        PHASE_PTRS();
        int kq = 256, kkv = 128; asm volatile("" : "+s"(kq), "+s"(kkv));
        const int hq = G / 2;
        if (bx < hq) { pg8::Gemm g{Z, WUP, T_TOK, 768, kq, ZLD}; IdleOrder S{0, bx, hq, (T_TOK / 256) * 3, 3};
          EpiUp<false> E{QR, KM, VM, SSQ, SSKV, KRR, KRSS, mla_k_norm_g}; pg8::gemm_phase(lds, g, S, E); }
        else { pg8::Gemm g{Z + 256, WUKV, T_TOK, 1024, kkv, ZLD}; IdleOrder S{0, bx - hq, G - hq, (T_TOK / 256) * 4, 4};
          EpiUp<true> E{QR, KM, VM, SSQ, SSKV, KRR, KRSS, mla_k_norm_g}; pg8::gemm_phase(lds, g, S, E); }
        if (BOTH(2)) GRID_BAR();
    }
    if (IN(3)) {
        PHASE_PTRS();
        const bool att_fixed_mla = BTAB[4097] >= 0.f && BTAB[4097] < 64.0f, att_fixed_diff = BTAB[4098] >= 0.f && BTAB[4098] < 64.0f;
        if (vcu < 256) { const int vu = vcu;
        const int s = vu & 7, bh = vu >> 3;
        for (int i_ = 0; i_ < 4 * NREP(3); ++i_) { const int i = i_ & 3; const int qb = (i == 0) ? s : (i == 1) ? 15 - s : (i == 2) ? 16 + s : 31 - s;
            const int b = bh >> 3, h = bh & 7;
            attn::UnitP P{QR + 96 * h, 768, KM + kimg(12, b * 8 + h, 0, 0, 0), 0, VM + vimg(2, b * 8 + h, 0, 0, 0, 0, 0), 0, Y + 64 * h, 1024, qb, (long)b * SEQ, nullptr, BTAB + 4097, nullptr, nullptr, nullptr, nullptr};
#ifndef NO_MLA
            if (IW_MLA && att_fixed_mla) attn::attn_unit_iw<6, 2, true>(P, lds, ROPE, mla_q_norm_g); else attn::attn_unit<6, 2, true>(P, lds, ROPE, mla_q_norm_g);
#endif
            }
        for (int i_ = 0; i_ < 4 * NREP(4); ++i_) { const int i = i_ & 3; const int half = bh & 1, h = (bh >> 1) & 3, b = bh >> 3, m = i & 1;
            const int qb = (half == 0) ? ((i < 2) ? s : 31 - s) : ((i < 2) ? 8 + s : 23 - s); const int hm = 2 * h + m;
            attn::UnitP P{Z + Z_DQ + 64 * hm, ZLD, DKI + kimg(8, b * 8 + hm, 0, 0, 0), 0, DVI + vimg(4, b * 4 + h, 0, 0, 0, 0, 0), 0, OD + 128 * hm, 1024, qb, (long)b * SEQ, BTAB + 1024 * h, BTAB + 4098,
                          m ? OD + 128 * (2 * h) : nullptr, Y + 512 + 128 * h, diff_out_norm_g, BTAB + 4096};
#ifndef NO_DIFF
            if (IW_DIFF && att_fixed_diff) attn::attn_unit_iw2<4, 4, false>(P, lds, nullptr, nullptr); else attn::attn_unit<4, 4, false>(P, lds, nullptr, nullptr);
#endif
            }
        }
        if (BOTH(3)) GRID_BAR();
    }
    if (IN(5)) for (int rep_ = 0; rep_ < NREP(5); ++rep_) {
        PHASE_PTRS();
        pg8::Gemm g{Y, WOUT, T_TOK, 1024, 1024, 1024}; pg8::StaticOrder S; S.init(T_TOK, 1024, G, bx);
        EpiRes<false> E{x, X1B, SS1};
        pg8::gemm_phase(lds, g, S, E);
        if (BOTH(5)) GRID_BAR();
    }
    if (IN(6)) for (int rep_ = 0; rep_ < NREP(6); ++rep_) {
        PHASE_PTRS();
        pg8::Gemm g{X1B, WG, T_TOK, D_FF, 1024, 1024}; pg8::StaticOrder S; S.init(T_TOK, D_FF, G, bx);
        EpiGate E{GT, SS1};
        pg8::gemm_phase(lds, g, S, E);
        { const int nbusy = (T_TOK / 256) * (D_FF / 256) % G;
          if (nbusy > 0 && bx >= nbusy) { const int ic = bx - nbusy, per = (256 + (G - nbusy) - 1) / (G - nbusy);
              const int u0 = per * ic, u1 = (u0 + per < 256 ? u0 + per : 256);
              if (u0 < 256) { const int r0 = (u0 >> 2) * 256, r1 = ((u1 - 1) >> 2) * 256 + 256; convert_p_rows(p_in, PB, r0, r1 - r0, tid); }
              pg8::Gemm g2{PB, WPP, T_TOK, 1024, 256, 256}; PanelOrder S2{0, ic, per, 256}; EpiBf E2{PRB}; pg8::gemm_phase(lds, g2, S2, E2); } }
        if (BOTH(6)) GRID_BAR();
    }
    if (IN(7)) for (int rep_ = 0; rep_ < NREP(7); ++rep_) {
        PHASE_PTRS();
        pg8::Gemm g{X1B, WU, T_TOK, D_FF, 1024, 1024}; pg8::StaticOrder S; S.init(T_TOK, D_FF, G, bx);
        EpiUpAct E{GT, ACT, SS1, conv_w, conv_b};
        pg8::gemm_phase(lds, g, S, E);
        { const int nbusy = (T_TOK / 256) * (D_FF / 256) % G;
          if (nbusy > 0 && bx >= nbusy) { const int ic = bx - nbusy, per = (256 + (G - nbusy) - 1) / (G - nbusy);
              const int u0 = per * ic, u1 = (u0 + per < 256 ? u0 + per : 256);
              if (u0 < 256) { const int r0 = ((256 + u0) >> 2) * 256, r1 = ((256 + u1 - 1) >> 2) * 256 + 256; convert_p_rows(p_in, PB, r0, r1 - r0, tid); }
              pg8::Gemm g2{PB, WPP, T_TOK, 1024, 256, 256}; PanelOrder S2{256, ic, per, 256}; EpiBf E2{PRB}; pg8::gemm_phase(lds, g2, S2, E2); }
          else if (nbusy == 0) { pg8::Gemm g2{PB, WPP, T_TOK, 1024, 256, 256}; pg8::StaticOrder S2; S2.init(T_TOK, 1024, G, bx); EpiBf E2{PRB}; pg8::gemm_phase(lds, g2, S2, E2); }
          {
            constexpr int J_D = 32 * 44, J_PG = 32 * 16; LAS float* scr = (LAS float*)(lds + wave * 16384);
            const int w0 = nbusy > 0 ? (bx - nbusy) * NWAVES + wave : bx * NWAVES + wave, nw = (nbusy > 0 ? (G - nbusy) : G) * NWAVES;
            if (nbusy == 0 || bx >= nbusy)
                for (int it = w0; it < J_D + J_PG; it += nw) {
                    if (it < J_D) wt_item(w_down, 1024, 32 * (it / 44), 64 * (it % 44), nullptr, WD, D_FF, 32 * (it / 44), 64 * (it % 44), scr, lane);
                    else { const int r = it - J_D; wt_item(w_ple_gate, 1024, 32 * (r / 16), 64 * (r % 16), ple_norm_g, WPG, 1024, 32 * (r / 16), 64 * (r % 16), scr, lane); } } }
        }
        if (BOTH(7)) GRID_BAR();
    }
    if (IN(8)) {
        PHASE_PTRS();
        pg8::Gemm g{ACT, WD, T_TOK, 1024, D_FF, D_FF}; pg8::StaticOrder S; S.init(T_TOK, 1024, G, bx);
        EpiRes<true> E{X1B, X2B, SS2};
        pg8::gemm_phase(lds, g, S, E);
        if (BOTH(8)) GRID_BAR();
    }
    if (IN(9)) {
        PHASE_PTRS();
        { pg8::Gemm g{X2B, WPG, T_TOK, 1024, 1024, 1024}; pg8::StaticOrder S; S.init(T_TOK, 1024, G, bx); EpiPle E{out, X2B, PRB, SS2}; pg8::gemm_phase(lds, g, S, E); }
    }
#undef IN
#undef BOTH
#undef GRID_BAR
}

extern "C" void kernel_launch(void* const* d_in, const int* in_sizes, int n_in, void* d_out, int out_size, void* d_ws, size_t ws_size, hipStream_t stream) {
    static int grid = 0;
    if (grid == 0) {
        if (n_in != 28 || out_size != T_TOK * D_MODEL || ws_size < WS_END) { fprintf(stderr, "kernel_launch: unexpected shapes (n_in %d out %d ws %zu)\n", n_in, out_size, ws_size); grid = -1; return; }
        int dev = 0, cus = 0, per_cu = 0;
        if (hipGetDevice(&dev) != hipSuccess || hipDeviceGetAttribute(&cus, hipDeviceAttributeMultiprocessorCount, dev) != hipSuccess) { grid = -1; return; }
        if (hipFuncSetAttribute((const void*)mk_fwd, hipFuncAttributeMaxDynamicSharedMemorySize, LDS_BYTES) != hipSuccess) { fprintf(stderr, "kernel_launch: hipFuncSetAttribute failed\n"); grid = -1; return; }
        if (hipOccupancyMaxActiveBlocksPerMultiprocessor(&per_cu, (const void*)mk_fwd, NWAVES * 64, LDS_BYTES) != hipSuccess || per_cu < 1) { fprintf(stderr, "kernel_launch: occupancy query says %d blocks per CU\n", per_cu); }
        (void)hipGetLastError();
        grid = cus;
    }
    if (grid < 0) return;
    (void)hipMemsetAsync((char*)d_ws + WS_CTL, 0, CTL_ZERO_BYTES, stream);
    Args a{};
    for (int i = 0; i < 28; ++i) a.in[i] = (const float*)d_in[i];
    a.out = (float*)d_out; a.ws = (unsigned char*)d_ws;
#if MK_N_LAUNCHES == 1
    a.ph_lo = 0; a.ph_hi = N_PHASES;
    void* kargs[] = {&a};
    hipError_t e = hipLaunchCooperativeKernel((const void*)mk_fwd, dim3(grid), dim3(NWAVES * 64), kargs, LDS_BYTES, stream);
    if (e != hipSuccess) fprintf(stderr, "kernel_launch: cooperative launch failed: %s (grid %d)\n", hipGetErrorString(e), grid);
#else
    for (int ph = 0; ph < N_PHASES; ++ph) { a.ph_lo = ph; a.ph_hi = ph + 1; hipLaunchKernelGGL(mk_fwd, dim3(grid), dim3(NWAVES * 64), LDS_BYTES, stream, a); }
#endif
}
```

```cpp
#include <hip/hip_runtime.h>
#include <cstdio>
#include <cstdint>
#include <cmath>

#define LAS __attribute__((address_space(3)))
#define GAS __attribute__((address_space(1)))
typedef unsigned short bf16_t;
typedef short bf16x8 __attribute__((ext_vector_type(8)));
typedef short s16x4 __attribute__((ext_vector_type(4)));
typedef float f32x2 __attribute__((ext_vector_type(2)));
typedef float f32x4 __attribute__((ext_vector_type(4)));
typedef float f32x16 __attribute__((ext_vector_type(16)));
typedef unsigned u32x2 __attribute__((ext_vector_type(2)));
typedef unsigned u32x4 __attribute__((ext_vector_type(4)));
typedef __bf16 bf16x2_t __attribute__((ext_vector_type(2)));

constexpr int D_MODEL = 1024, BATCH = 4, SEQ = 8192, PLE_DIM = 256, T_TOK = BATCH * SEQ;
constexpr int D_FF = 2816;
constexpr int OFF_Q_LAT = 0, OFF_KV_LAT = 256, OFF_K_ROPE = 384, OFF_DIFF_Q = 416, OFF_DIFF_K = 928, OFF_DIFF_V = 1440, IN_COLS = 1952;
constexpr float EPS = 1e-6f;
constexpr float LOG2E = 1.4426950408889634f;
constexpr int ZLD = 1024;
constexpr int Z_DQ = 512;
__host__ __device__ __forceinline__ size_t kimg(int nch, int bh, int t, int c, int r) { return ((((size_t)bh * (SEQ / 64) + t) * nch + c) * 64 + r) * 8; }
__host__ __device__ __forceinline__ size_t vimg(int nd, int bh, int t, int d0, int ks, int r16, int col) { return ((((size_t)bh * (SEQ / 64) + t) * nd + d0) * 4 + ks) * 512 + r16 * 32 + col; }

__device__ __forceinline__ unsigned cvtpk(float lo, float hi) { f32x2 v = {lo, hi}; bf16x2_t b = __builtin_convertvector(v, bf16x2_t); return __builtin_bit_cast(unsigned, b); }
__device__ __forceinline__ float bf2f(short h) { return __uint_as_float(((unsigned)(unsigned short)h) << 16); }
__device__ __forceinline__ float bflo(unsigned w) { return __uint_as_float(w << 16); }
__device__ __forceinline__ float bfhi(unsigned w) { return __uint_as_float(w & 0xffff0000u); }

namespace pg8 {
constexpr int BM = 256, BK = 64, HALF = 128, HTB = HALF * BK * 2, STAGE_BYTES = 8 * HTB, NXCD = 8, WGM = 8;
__host__ __device__ __forceinline__ int lds_byte(int r, int c) { const int st = (r >> 4) * 2 + (c >> 5), rr = r & 15, cc = c & 31, ob = rr * 64 + cc * 2; return st * 1024 + (ob ^ (((ob >> 9) & 1) << 5)); }
__host__ __device__ __forceinline__ void stage_rc(int b, int& R, int& C) { const int st = b / 1024, sb = b % 1024, swz = sb ^ (((sb >> 9) & 1) << 5); R = (st >> 1) * 16 + swz / 64; C = (st & 1) * 32 + (swz % 64) / 2; }
__host__ __device__ __forceinline__ int perm32(int rho) { const int n = rho >> 4, i = rho & 15; return 8 * (i >> 2) + 4 * n + (i & 3); }

struct Unit { int pm, pn; };
struct Gemm { const bf16_t* A; const bf16_t* Bt; int M, N, K, lda; };

struct StaticOrder {
    int nM, nN, nwg, G, c;
    __host__ __device__ void init(int M, int N, int G_, int c_) { nM = M / BM; nN = N / BM; nwg = nM * nN; G = G_; c = c_; }
    __host__ __device__ bool next(int i, Unit& u) const {
        const long L = (long)i * G + c; if (L >= nwg) return false;
        int wgid = (int)L; { const int q = nwg / NXCD, r = nwg % NXCD, xcd = wgid % NXCD, off = wgid / NXCD; wgid = (xcd < r ? xcd * (q + 1) : r * (q + 1) + (xcd - r) * q) + off; }
        const int nig = WGM * nN, gid = wgid / nig, fm = gid * WGM, gsz = (nM - fm) < WGM ? (nM - fm) : WGM;
        u.pm = fm + ((wgid % nig) % gsz); u.pn = (wgid % nig) / gsz; return true;
    }
};

template <class Epi, class Sched>
__device__ __forceinline__ void gemm_phase(LAS unsigned char* lds, const Gemm g, const Sched& S, const Epi& E) {
    int tid = threadIdx.x; asm volatile("" : "+v"(tid));
    const int wid = __builtin_amdgcn_readfirstlane(tid >> 6), lane = tid & 63, wr = wid >> 2, wc = wid & 3, fr = lane & 15, fq = lane >> 4;
    const int K = g.K, nt = K / BK, lda = g.lda;
    unsigned voffA[2], voffB[2];
#pragma unroll
    for (int i = 0; i < 2; ++i) { int R, C; stage_rc(tid * 16 + i * 8192, R, C); const int Rb = (R & ~31) + perm32(R & 31);
        voffA[i] = (unsigned)(R * lda + C) * 2u; voffB[i] = (unsigned)(Rb * K + C) * 2u; }
    const size_t kstep = (size_t)(BK * 2);
    const size_t hstepA = (size_t)HALF * lda * 2, hstepB = (size_t)HALF * K * 2;
    const size_t tstepA = 2 * hstepA, tstepB = 2 * hstepB;
    const unsigned ldsw = (unsigned)wid * 1024u;
    const int aoff = lds_byte(wr * 64 + fr, fq * 8), boff = lds_byte(wc * 32 + fr, fq * 8);
#define PG8_SA(b, h) (((b) * 2 + (h)) * HTB)
#define PG8_SB(b, h) ((4 + (b) * 2 + (h)) * HTB)
#define PG8_STAGE(bufoff, gbase, voff) do { _Pragma("unroll") for (int _i = 0; _i < 2; ++_i) \
        __builtin_amdgcn_global_load_lds((const unsigned*)((const char*)(gbase) + (voff)[_i]), (LAS unsigned*)(lds + (bufoff) + ldsw + _i * 8192), 16, 0, 0); } while (0)
#define PG8_LDA(dst, b, h) do { _Pragma("unroll") for (int m = 0; m < 4; ++m) _Pragma("unroll") for (int k = 0; k < 2; ++k) dst[m][k] = *(const LAS bf16x8*)(lds + PG8_SA(b, h) + aoff + m * 2048 + k * 1024); } while (0)
#define PG8_LDB(dst, b, h) do { _Pragma("unroll") for (int n = 0; n < 2; ++n) _Pragma("unroll") for (int k = 0; k < 2; ++k) dst[n][k] = *(const LAS bf16x8*)(lds + PG8_SB(b, h) + boff + n * 2048 + k * 1024); } while (0)
#define PG8_MMA(ai, bj, At, Bt) do { __builtin_amdgcn_s_setprio(1); _Pragma("unroll") for (int m = 0; m < 4; ++m) _Pragma("unroll") for (int n = 0; n < 2; ++n) _Pragma("unroll") for (int k = 0; k < 2; ++k) \
        acc[ai][bj][m][n] = __builtin_amdgcn_mfma_f32_16x16x32_bf16(Bt[n][k], At[m][k], acc[ai][bj][m][n], 0, 0, 0); __builtin_amdgcn_s_setprio(0); } while (0)
#define PG8_WAIT_V(n) asm volatile("s_waitcnt vmcnt(" #n ")" ::: "memory")
#define PG8_WAIT_L(n) asm volatile("s_waitcnt lgkmcnt(" #n ")" ::: "memory")
#define PG8_BAR __builtin_amdgcn_s_barrier()
#define PG8_SCHED __builtin_amdgcn_sched_barrier(0)
    Unit cur, nxt; int ui = 0;
    if (!S.next(0, cur)) return;
    f32x4 acc[2][2][4][2];
#pragma unroll
    for (int a = 0; a < 2; ++a)
#pragma unroll
        for (int b = 0; b < 2; ++b)
#pragma unroll
            for (int m = 0; m < 4; ++m)
#pragma unroll
                for (int n = 0; n < 2; ++n) acc[a][b][m][n] = (f32x4){0.f, 0.f, 0.f, 0.f};
    bf16x8 At[4][2], B0[2][2], B1[2][2];
    const char* cA = (const char*)g.A + (size_t)cur.pm * tstepA; const char* cB = (const char*)g.Bt + (size_t)cur.pn * tstepB;
    PG8_STAGE(PG8_SB(0, 0), cB, voffB); PG8_STAGE(PG8_SB(0, 1), cB + hstepB, voffB); PG8_STAGE(PG8_SA(0, 0), cA, voffA); PG8_STAGE(PG8_SA(0, 1), cA + hstepA, voffA);
    if (wr == 1) PG8_BAR;
    PG8_WAIT_V(2); PG8_BAR;
    PG8_STAGE(PG8_SB(1, 0), cB + kstep, voffB); PG8_STAGE(PG8_SA(1, 0), cA + kstep, voffA); PG8_STAGE(PG8_SB(1, 1), cB + hstepB + kstep, voffB);
    PG8_WAIT_V(6); PG8_BAR;
    for (;;) {
        const bool has_next = S.next(ui + 1, nxt);
        const char* nA = has_next ? (const char*)g.A + (size_t)nxt.pm * tstepA : cA; const char* nB = has_next ? (const char*)g.Bt + (size_t)nxt.pn * tstepB : cB;
#pragma unroll 1
        for (int t = 0; t < nt; t += 2) {
            const bool last = (t == nt - 2);
            const char* a1 = cA + (size_t)(t + 1) * kstep;
            const char* a2 = last ? nA : cA + (size_t)(t + 2) * kstep; const char* b2 = last ? nB : cB + (size_t)(t + 2) * kstep;
            const char* a3 = a2 + kstep; const char* b3 = b2 + kstep;
            PG8_LDB(B0, 0, 0); PG8_LDB(B1, 0, 1); PG8_SCHED; PG8_LDA(At, 0, 0); PG8_STAGE(PG8_SA(1, 1), a1 + hstepA, voffA);
            PG8_WAIT_V(8); PG8_WAIT_L(0); PG8_BAR; PG8_MMA(0, 0, At, B0); PG8_MMA(0, 1, At, B1); PG8_BAR; PG8_SCHED;
            PG8_LDA(At, 0, 1); PG8_STAGE(PG8_SB(0, 0), b2, voffB); PG8_STAGE(PG8_SB(0, 1), b2 + hstepB, voffB); PG8_STAGE(PG8_SA(0, 0), a2, voffA);
            PG8_WAIT_V(8); PG8_WAIT_L(0); PG8_BAR; PG8_MMA(1, 0, At, B0); PG8_MMA(1, 1, At, B1); PG8_BAR; PG8_SCHED;
            PG8_LDB(B0, 1, 0); PG8_LDB(B1, 1, 1); PG8_SCHED; PG8_LDA(At, 1, 0); PG8_STAGE(PG8_SA(0, 1), a2 + hstepA, voffA);
            PG8_WAIT_V(8); PG8_WAIT_L(0); PG8_BAR; PG8_MMA(0, 0, At, B0); PG8_MMA(0, 1, At, B1); PG8_BAR; PG8_SCHED;
            PG8_LDA(At, 1, 1); PG8_STAGE(PG8_SB(1, 0), b3, voffB); PG8_STAGE(PG8_SB(1, 1), b3 + hstepB, voffB); PG8_STAGE(PG8_SA(1, 0), a3, voffA);
            PG8_WAIT_V(8); PG8_WAIT_L(0); PG8_BAR; PG8_MMA(1, 0, At, B0); PG8_MMA(1, 1, At, B1); PG8_BAR; PG8_SCHED;
        }
        if (wr == 0) PG8_BAR;
        E(acc, cur, wr, wc, fr, fq);
        if (!has_next) break;
#pragma unroll
        for (int a = 0; a < 2; ++a)
#pragma unroll
            for (int b = 0; b < 2; ++b)
#pragma unroll
                for (int m = 0; m < 4; ++m)
#pragma unroll
                    for (int n = 0; n < 2; ++n) acc[a][b][m][n] = (f32x4){0.f, 0.f, 0.f, 0.f};
        cur = nxt; cA = nA; cB = nB; ++ui;
        if (wr == 1) PG8_BAR;
    }
    PG8_WAIT_V(0);
    PG8_BAR;
#undef PG8_SA
#undef PG8_SB
#undef PG8_STAGE
#undef PG8_LDA
#undef PG8_LDB
#undef PG8_MMA
#undef PG8_WAIT_V
#undef PG8_WAIT_L
#undef PG8_BAR
#undef PG8_SCHED
}
}

constexpr int NWAVES_C = 8;
typedef f32x4 AccT[2][2][4][2];
__device__ __forceinline__ u32x4 pack8(const f32x4 a, const f32x4 b) { u32x4 w; w.x = cvtpk(a[0], a[1]); w.y = cvtpk(a[2], a[3]); w.z = cvtpk(b[0], b[1]); w.w = cvtpk(b[2], b[3]); return w; }
__device__ __forceinline__ float sq4(const f32x4 a) { return (a[0] * a[0] + a[1] * a[1]) + (a[2] * a[2] + a[3] * a[3]); }
__device__ __forceinline__ float red_fq(float s) { s += __shfl_xor(s, 16); s += __shfl_xor(s, 32); return s; }

struct EpiIn {
    bf16_t* Z; bf16_t* DKI; bf16_t* DVI; float* SSQ; float* SSKV; float* KRR; float* KRSS; const float* rope; const float* gdq; const float* gdk; const float* gmk;
    __device__ __forceinline__ void operator()(const AccT& acc, const pg8::Unit& u, int wr, int wc, int fr, int fq) const {
        const int pn = u.pn, row0 = u.pm * 256 + wr * 64 + fr;
        if (pn >= 6) {
#pragma unroll
            for (int ai = 0; ai < 2; ++ai)
#pragma unroll
                for (int m = 0; m < 4; ++m) { const int row = row0 + ai * 128 + m * 16, b = row >> 13, sq = row & (SEQ - 1);
#pragma unroll
                    for (int bj = 0; bj < 2; ++bj) { const int p = (pn - 6) * 256 + bj * 128 + wc * 32 + 8 * fq;
                        *(u32x4*)(DVI + vimg(4, b * 4 + (p >> 7), sq >> 6, (p & 127) >> 5, (sq & 63) >> 4, sq & 15, p & 31)) = pack8(acc[ai][bj][m][0], acc[ai][bj][m][1]); } }
        } else if (pn == 0) {
#pragma unroll
            for (int ai = 0; ai < 2; ++ai)
#pragma unroll
                for (int m = 0; m < 4; ++m) { const int row = row0 + ai * 128 + m * 16; bf16_t* rp = Z + (size_t)row * ZLD + pn * 256 + wc * 32 + 8 * fq; float s = 0.f;
#pragma unroll
                    for (int bj = 0; bj < 2; ++bj) { *(u32x4*)(rp + bj * 128) = pack8(acc[ai][bj][m][0], acc[ai][bj][m][1]); s += sq4(acc[ai][bj][m][0]) + sq4(acc[ai][bj][m][1]); }
                    if (pn == 0) { s = red_fq(s); if (fq == 0) SSQ[(size_t)row * 4 + wc] = s; } }
        } else if (pn == 1) {
#pragma unroll
            for (int ai = 0; ai < 2; ++ai)
#pragma unroll
                for (int m = 0; m < 4; ++m) { const int row = row0 + ai * 128 + m * 16;
                    *(u32x4*)(Z + (size_t)row * ZLD + 256 + wc * 32 + 8 * fq) = pack8(acc[ai][0][m][0], acc[ai][0][m][1]);
                    float s = red_fq(sq4(acc[ai][0][m][0]) + sq4(acc[ai][0][m][1])); if (fq == 0) SSKV[(size_t)row * 4 + wc] = s;
                    if (wc == 0) {
                        const f32x4 v0 = acc[ai][1][m][0], v1 = acc[ai][1][m][1];
                        float ss = red_fq(sq4(v0) + sq4(v1)); if (fq == 0) KRSS[row] = ss;
                        const f32x4 g0 = *(const f32x4*)(gmk + 64 + 8 * fq), g1 = *(const f32x4*)(gmk + 64 + 8 * fq + 4);
                        const f32x4 a0 = v0 * g0, a1 = v1 * g1;
                        f32x4 b0, b1;
#pragma unroll
                        for (int e = 0; e < 4; ++e) { b0[e] = __shfl_xor(a0[e], 32); b1[e] = __shfl_xor(a1[e], 32); }
                        const int pos = row & (SEQ - 1); const float* rp = rope + (size_t)pos * 32 + 8 * (fq & 1);
                        const f32x4 c0 = *(const f32x4*)(rp), c1 = *(const f32x4*)(rp + 4), s0 = *(const f32x4*)(rp + 16), s1 = *(const f32x4*)(rp + 20);
                        f32x4 o0, o1;
                        if (fq < 2) { o0 = a0 * c0 - b0 * s0; o1 = a1 * c1 - b1 * s1; } else { o0 = a0 * c0 + b0 * s0; o1 = a1 * c1 + b1 * s1; }
                        *(f32x4*)(KRR + (size_t)row * 32 + 8 * fq) = o0; *(f32x4*)(KRR + (size_t)row * 32 + 8 * fq + 4) = o1;
                    } }
        } else {
            const bool isq = pn < 4; const float* g = isq ? gdq : gdk; const float sc = isq ? 0.125f * LOG2E : 1.0f;
            const int G = 4 * ((pn - 2) & 1) + wc; const int colb = Z_DQ + 64 * G + 8 * fq;
            f32x4 gg[2][2];
#pragma unroll
            for (int bj = 0; bj < 2; ++bj) { gg[bj][0] = *(const f32x4*)(g + 32 * bj + 8 * fq) * sc; gg[bj][1] = *(const f32x4*)(g + 32 * bj + 8 * fq + 4) * sc; }
#pragma unroll
            for (int ai = 0; ai < 2; ++ai)
#pragma unroll
                for (int m = 0; m < 4; ++m) { const int row = row0 + ai * 128 + m * 16;
                    float s = (sq4(acc[ai][0][m][0]) + sq4(acc[ai][0][m][1])) + (sq4(acc[ai][1][m][0]) + sq4(acc[ai][1][m][1])); s = red_fq(s);
                    const float r = rsqrtf(s * (1.0f / 64.0f) + EPS);
#pragma unroll
                    for (int bj = 0; bj < 2; ++bj) { const u32x4 w = pack8(acc[ai][bj][m][0] * gg[bj][0] * r, acc[ai][bj][m][1] * gg[bj][1] * r);
                        if (isq) *(u32x4*)(Z + (size_t)row * ZLD + colb + 32 * bj) = w;
                        else *(u32x4*)(DKI + kimg(8, (row >> 13) * 8 + G, (row & (SEQ - 1)) >> 6, 4 * bj + fq, row & 63)) = w; } }
        }
    }
};

template <bool KV> struct EpiUp {
    bf16_t* QR; bf16_t* KM; bf16_t* VM; const float* SSQ; const float* SSKV; const float* KRR; const float* KRSS; const float* gmk;
    __device__ __forceinline__ void operator()(const AccT& acc, const pg8::Unit& u, int wr, int wc, int fr, int fq) const {
        const int pn = u.pn, row0 = u.pm * 256 + wr * 64 + fr;
        if (!KV || pn >= 2) {
            const float* SSp = KV ? SSKV : SSQ; const float inv = KV ? (1.0f / 128.0f) : (1.0f / 256.0f);
#pragma unroll
            for (int ai = 0; ai < 2; ++ai)
#pragma unroll
                for (int m = 0; m < 4; ++m) { const int row = row0 + ai * 128 + m * 16;
                    const f32x4 s4 = *(const f32x4*)(SSp + (size_t)row * 4); const float r = rsqrtf(((s4[0] + s4[1]) + (s4[2] + s4[3])) * inv + EPS);
#pragma unroll
                    for (int bj = 0; bj < 2; ++bj) { const u32x4 w = pack8(acc[ai][bj][m][0] * r, acc[ai][bj][m][1] * r);
                        if (!KV) *(u32x4*)(QR + (size_t)row * 768 + pn * 256 + bj * 128 + wc * 32 + 8 * fq) = w;
                        else { const int p = (pn - 2) * 256 + bj * 128 + wc * 32 + 8 * fq, sq = row & (SEQ - 1);
                            *(u32x4*)(VM + vimg(2, (row >> 13) * 8 + (p >> 6), sq >> 6, (p & 63) >> 5, (sq & 63) >> 4, sq & 15, p & 31)) = w; } }
                    if (m & 1) asm volatile("" ::: "memory"); }
        } else {
            const int hh = 4 * pn + wc;
            f32x4 gg[2][2];
#pragma unroll
            for (int bj = 0; bj < 2; ++bj) { gg[bj][0] = *(const f32x4*)(gmk + 32 * bj + 8 * fq); gg[bj][1] = *(const f32x4*)(gmk + 32 * bj + 8 * fq + 4); }
#pragma unroll
            for (int ai = 0; ai < 2; ++ai)
#pragma unroll
                for (int m = 0; m < 4; ++m) { const int row = row0 + ai * 128 + m * 16;
                    const f32x4 s4 = *(const f32x4*)(SSKV + (size_t)row * 4); const float r = rsqrtf(((s4[0] + s4[1]) + (s4[2] + s4[3])) * (1.0f / 128.0f) + EPS);
                    float s = (sq4(acc[ai][0][m][0]) + sq4(acc[ai][0][m][1])) + (sq4(acc[ai][1][m][0]) + sq4(acc[ai][1][m][1]));
                    s = red_fq(s) * (r * r);
                    const float rk = rsqrtf((s + KRSS[row]) * (1.0f / 96.0f) + EPS), rr = r * rk;
                    const int bhk = (row >> 13) * 8 + hh, tk = (row & (SEQ - 1)) >> 6, rwk = row & 63;
#pragma unroll
                    for (int bj = 0; bj < 2; ++bj) *(u32x4*)(KM + kimg(12, bhk, tk, 4 * bj + fq, rwk)) = pack8(acc[ai][bj][m][0] * gg[bj][0] * rr, acc[ai][bj][m][1] * gg[bj][1] * rr);
                    const f32x4 k0 = *(const f32x4*)(KRR + (size_t)row * 32 + 8 * fq), k1 = *(const f32x4*)(KRR + (size_t)row * 32 + 8 * fq + 4);
                    *(u32x4*)(KM + kimg(12, bhk, tk, 8 + fq, rwk)) = pack8(k0 * rk, k1 * rk);
                    asm volatile("" ::: "memory"); }
        }
    }
};

template <bool XI_BF16> struct EpiRes {
    const void* xi; bf16_t* XB; float* SS;
    __device__ __forceinline__ void operator()(const AccT& acc, const pg8::Unit& u, int wr, int wc, int fr, int fq) const {
        const int row0 = u.pm * 256 + wr * 64 + fr, col0 = u.pn * 256 + wc * 32 + 8 * fq;
#pragma unroll
        for (int ai = 0; ai < 2; ++ai) {
            u32x4 rb[4][2]; f32x4 rf[4][2][2];
#pragma unroll
            for (int m = 0; m < 4; ++m) { const size_t off = (size_t)(row0 + ai * 128 + m * 16) * D_MODEL + col0;
#pragma unroll
                for (int bj = 0; bj < 2; ++bj) {
                    if constexpr (XI_BF16) rb[m][bj] = *(const u32x4*)((const bf16_t*)xi + off + bj * 128);
                    else { rf[m][bj][0] = *(const f32x4*)((const float*)xi + off + bj * 128); rf[m][bj][1] = *(const f32x4*)((const float*)xi + off + bj * 128 + 4); } } }
#pragma unroll
            for (int m = 0; m < 4; ++m) { const int row = row0 + ai * 128 + m * 16; const size_t off = (size_t)row * D_MODEL + col0; float s = 0.f;
#pragma unroll
                for (int bj = 0; bj < 2; ++bj) { f32x4 a, b;
                    if constexpr (XI_BF16) { const u32x4 w = rb[m][bj]; a = (f32x4){bflo(w.x), bfhi(w.x), bflo(w.y), bfhi(w.y)}; b = (f32x4){bflo(w.z), bfhi(w.z), bflo(w.w), bfhi(w.w)}; }
                    else { a = rf[m][bj][0]; b = rf[m][bj][1]; }
                    a += acc[ai][bj][m][0]; b += acc[ai][bj][m][1];
                    *(u32x4*)(XB + off + bj * 128) = pack8(a, b); s += sq4(a) + sq4(b); }
                s = red_fq(s); if (fq == 0) SS[(size_t)row * 16 + u.pn * 4 + wc] = s; }
            asm volatile("" ::: "memory"); }
    }
};
__device__ __forceinline__ float rstd_from16(const float* SS, int row, int fq) {
    const f32x4 s4 = *(const f32x4*)(SS + (size_t)row * 16 + 4 * fq); const float s = red_fq((s4[0] + s4[1]) + (s4[2] + s4[3]));
    return rsqrtf(s * (1.0f / 1024.0f) + EPS);
}
struct EpiGate {
    bf16_t* Gt; const float* SS;
    __device__ __forceinline__ void operator()(const AccT& acc, const pg8::Unit& u, int wr, int wc, int fr, int fq) const {
        const int row0 = u.pm * 256 + wr * 64 + fr, col0 = u.pn * 256 + wc * 32 + 8 * fq;
#pragma unroll
        for (int ai = 0; ai < 2; ++ai)
#pragma unroll
            for (int m = 0; m < 4; ++m) { const int row = row0 + ai * 128 + m * 16; const float r = rstd_from16(SS, row, fq);
#pragma unroll
                for (int bj = 0; bj < 2; ++bj) *(u32x4*)(Gt + (size_t)row * D_FF + col0 + bj * 128) = pack8(acc[ai][bj][m][0] * r, acc[ai][bj][m][1] * r); }
    }
};
template <int CTRL> __device__ __forceinline__ unsigned dpp_ror(unsigned v) { return (unsigned)__builtin_amdgcn_update_dpp(0, (int)v, CTRL, 0xf, 0xf, false); }
struct EpiUpAct {
    const bf16_t* Gt; bf16_t* ACT; const float* SS; const float* cw; const float* cb;
    __device__ __forceinline__ void operator()(const AccT& acc, const pg8::Unit& u, int wr, int wc, int fr, int fq) const {
#pragma unroll
        for (int bj = 0; bj < 2; ++bj) { const int col = u.pn * 256 + bj * 128 + wc * 32 + 8 * fq;
            float w0[8], w1[8], w2[8], bb[8];
#pragma unroll
            for (int h = 0; h < 2; ++h) { const f32x4 a = *(const f32x4*)(cw + col + 4 * h), b = *(const f32x4*)(cw + D_FF + col + 4 * h), c = *(const f32x4*)(cw + 2 * D_FF + col + 4 * h), d = *(const f32x4*)(cb + col + 4 * h);
#pragma unroll
                for (int e = 0; e < 4; ++e) { w0[4 * h + e] = a[e]; w1[4 * h + e] = b[e]; w2[4 * h + e] = c[e]; bb[4 * h + e] = d[e]; } }
#pragma unroll
            for (int ai = 0; ai < 2; ++ai) { const int strip0 = u.pm * 256 + ai * 128 + wr * 64;
                const bool seq0 = (strip0 & (SEQ - 1)) == 0;
                u32x4 g[5];
                g[0] = (u32x4){0u, 0u, 0u, 0u};
                if (!seq0) g[0] = *(const u32x4*)(Gt + (size_t)(strip0 - 16 + fr) * D_FF + col);
#pragma unroll
                for (int m = 0; m < 4; ++m) g[m + 1] = *(const u32x4*)(Gt + (size_t)(strip0 + 16 * m + fr) * D_FF + col);
#pragma unroll
                for (int m = 0; m < 4; ++m) { const int row = strip0 + 16 * m + fr; const float r = rstd_from16(SS, row, fq);
                    float uu[8]; { const f32x4 a = acc[ai][bj][m][0] * r, b = acc[ai][bj][m][1] * r;
#pragma unroll
                        for (int e = 0; e < 4; ++e) { uu[e] = a[e]; uu[4 + e] = b[e]; } }
                    float o[8];
#pragma unroll
                    for (int w = 0; w < 4; ++w) { const unsigned x2 = g[m + 1][w];
                        const unsigned x1 = (unsigned)__builtin_amdgcn_update_dpp((int)dpp_ror<0x121>(g[m][w]), (int)g[m + 1][w], 0x111, 0xf, 0xf, false);
                        const unsigned x0 = (unsigned)__builtin_amdgcn_update_dpp((int)dpp_ror<0x122>(g[m][w]), (int)g[m + 1][w], 0x112, 0xf, 0xf, false);
#pragma unroll
                        for (int hh = 0; hh < 2; ++hh) { const int e = 2 * w + hh; const float a0 = hh ? bfhi(x0) : bflo(x0), a1 = hh ? bfhi(x1) : bflo(x1), a2 = hh ? bfhi(x2) : bflo(x2);
                            const float c = bb[e] + w0[e] * a0 + w1[e] * a1 + w2[e] * a2;
                            o[e] = c * __builtin_amdgcn_rcpf(1.0f + __builtin_amdgcn_exp2f(-c * LOG2E)) * uu[e]; } }
                    u32x4 wv; wv.x = cvtpk(o[0], o[1]); wv.y = cvtpk(o[2], o[3]); wv.z = cvtpk(o[4], o[5]); wv.w = cvtpk(o[6], o[7]);
                    *(u32x4*)(ACT + (size_t)row * D_FF + col) = wv; } } }
    }
};
struct EpiBf {
    bf16_t* O;
    __device__ __forceinline__ void operator()(const AccT& acc, const pg8::Unit& u, int wr, int wc, int fr, int fq) const {
        const int row0 = u.pm * 256 + wr * 64 + fr, col0 = u.pn * 256 + wc * 32 + 8 * fq;
#pragma unroll
        for (int ai = 0; ai < 2; ++ai)
#pragma unroll
            for (int m = 0; m < 4; ++m) { const size_t off = (size_t)(row0 + ai * 128 + m * 16) * D_MODEL + col0;
#pragma unroll
                for (int bj = 0; bj < 2; ++bj) *(u32x4*)(O + off + bj * 128) = pack8(acc[ai][bj][m][0], acc[ai][bj][m][1]); }
    }
};
struct EpiPle {
    float* xo; const bf16_t* X2; const bf16_t* PR; const float* SS;
    __device__ __forceinline__ void operator()(const AccT& acc, const pg8::Unit& u, int wr, int wc, int fr, int fq) const {
        const int row0 = u.pm * 256 + wr * 64 + fr, col0 = u.pn * 256 + wc * 32 + 8 * fq;
#pragma unroll
        for (int ai = 0; ai < 2; ++ai) {
            u32x4 xw[4][2], pq[4][2]; float rr[4];
#pragma unroll
            for (int m = 0; m < 4; ++m) { const int row = row0 + ai * 128 + m * 16; const size_t off = (size_t)row * D_MODEL + col0; rr[m] = rstd_from16(SS, row, fq);
#pragma unroll
                for (int bj = 0; bj < 2; ++bj) { xw[m][bj] = *(const u32x4*)(X2 + off + bj * 128); pq[m][bj] = *(const u32x4*)(PR + off + bj * 128); } }
#pragma unroll
            for (int m = 0; m < 4; ++m) { const size_t off = (size_t)(row0 + ai * 128 + m * 16) * D_MODEL + col0; const float r = rr[m];
#pragma unroll
                for (int bj = 0; bj < 2; ++bj) { const size_t o2 = off + bj * 128;
#pragma unroll
                    for (int n = 0; n < 2; ++n) { const unsigned x0 = n ? xw[m][bj].z : xw[m][bj].x, x1 = n ? xw[m][bj].w : xw[m][bj].y, q0 = n ? pq[m][bj].z : pq[m][bj].x, q1 = n ? pq[m][bj].w : pq[m][bj].y;
                        const f32x4 x2 = (f32x4){bflo(x0), bfhi(x0), bflo(x1), bfhi(x1)}, pr = (f32x4){bflo(q0), bfhi(q0), bflo(q1), bfhi(q1)}; const f32x4 gt = acc[ai][bj][m][n] * r; f32x4 o;
#pragma unroll
                        for (int e = 0; e < 4; ++e) o[e] = x2[e] + pr[e] * __builtin_amdgcn_rcpf(1.0f + __builtin_amdgcn_exp2f(-gt[e] * LOG2E));
                        *(f32x4*)(xo + o2 + 4 * n) = o; } } }
            asm volatile("" ::: "memory"); }
    }
};

struct IdleOrder {
    int base, ic, nidle, count, ncol;
    __device__ bool next(int i, pg8::Unit& u) const { const int v = ic + nidle * i; if (ic < 0 || v >= count) return false; const int w = base + v; u.pm = w / ncol; u.pn = w % ncol; return true; }
};
struct PanelOrder {
    int base, ic, per, count;
    __device__ bool next(int i, pg8::Unit& u) const { const int v = per * ic + i; if (i >= per || v >= count) return false; const int w = base + v; u.pm = w >> 2; u.pn = w & 3; return true; }
};
__device__ __forceinline__ void convert_p_rows(const float* p_in, bf16_t* PB, int row0, int nrows, int tid) {
    const size_t e0 = (size_t)row0 * PLE_DIM / 8, n8 = (size_t)nrows * PLE_DIM / 8;
    for (size_t i = tid; i < n8; i += 4 * NWAVES_C * 64) { f32x4 a[4], b[4];
#pragma unroll
        for (int q = 0; q < 4; ++q) { const size_t ii = i + (size_t)q * NWAVES_C * 64; if (ii < n8) { a[q] = __builtin_nontemporal_load((const GAS f32x4*)(p_in + (e0 + ii) * 8)); b[q] = __builtin_nontemporal_load((const GAS f32x4*)(p_in + (e0 + ii) * 8 + 4)); } }
#pragma unroll
        for (int q = 0; q < 4; ++q) { const size_t ii = i + (size_t)q * NWAVES_C * 64; if (ii < n8) *(GAS u32x4*)(PB + (e0 + ii) * 8) = pack8(a[q], b[q]); } }
    asm volatile("s_waitcnt vmcnt(0)" ::: "memory"); __syncthreads();
}

namespace attn {
__device__ __forceinline__ int crow(int r, int hi) { return (r & 3) + 8 * (r >> 2) + 4 * hi; }
__device__ __forceinline__ void glds16(const void* gbase, unsigned voff, unsigned lds_dst) { unsigned keep;
    asm volatile("s_mov_b32 %0, m0\n\ts_mov_b32 m0, %2\n\ts_nop 0\n\tglobal_load_lds_dwordx4 %1, %3\n\ts_mov_b32 m0, %0" : "=&s"(keep) : "v"(voff), "s"(lds_dst), "s"(gbase) : "memory"); }
typedef LAS const char* lds_cptr;
__device__ __forceinline__ s16x4 vtr(lds_cptr p) { return __builtin_bit_cast(s16x4, __builtin_amdgcn_ds_read_tr16_b64_v4i16((LAS s16x4*)p)); }
#define AT_WAITBAR(N) asm volatile("s_waitcnt vmcnt(" #N ") lgkmcnt(0)\n\ts_barrier" ::: "memory")
#define AT_BAR() asm volatile("s_waitcnt lgkmcnt(0)\n\ts_barrier" ::: "memory")
#define AT_WAITBAR_NL(N) asm volatile("s_waitcnt vmcnt(" #N ")\n\ts_barrier" ::: "memory")

template <int NKS, int ND, int NKSL = 3> struct Cfg {
    static constexpr int KSLOT = NKS * 2048, VSLOT = ND * 4096, NCH = NKS * 2;
    static constexpr int LDS_K = 0, LDS_V = NKSL * KSLOT, LDS_WS = LDS_V + 3 * VSLOT, LDS_OST = LDS_WS + 2048, OSTW = ND * 2048, LDS_BIAS = LDS_OST + 8 * OSTW, LDS_END = LDS_BIAS + 4096;
    static constexpr int NKD = (NCH > 8) ? 2 : 1, NVD = (ND * 4) / 8, NDMA = NKD + NVD;
};
struct UnitP { const bf16_t* Q; int ldq; const bf16_t* K; int ldk; const bf16_t* V; int ldv; bf16_t* O; int ldo; int qb; long rowbase; const float* btab; const float* bound; const bf16_t* O1; bf16_t* Yc; const float* gout; const float* lamp; unsigned* qhead; unsigned qbase; volatile LAS unsigned* qw; };

constexpr float THR = 8.0f;


template <int NKS, int ND, bool PV, bool QK> struct Ops {
    static constexpr int QCH = NKS / ND, B = (PV ? 4 : 0) + (QK ? 2 * QCH : 0), N = ND * B;
    static_assert(NKS % ND == 0, "k-steps split evenly over the d-blocks");
    __host__ __device__ static constexpr int kind(int i) { return (PV && (i % B) < 4) ? 0 : 1; }
    __host__ __device__ static constexpr int a(int i) { const int blk = i / B, j = i % B; return (PV && j < 4) ? blk : blk * QCH + (j - (PV ? 4 : 0)) / 2; }
    __host__ __device__ static constexpr int b(int i) { const int j = i % B; return (PV && j < 4) ? j : (j - (PV ? 4 : 0)) % 2; }
};
template <int NKS, int ND, bool PV, bool QK>
__device__ __forceinline__ void mfma_slot(f32x16 (&o)[ND], f32x16& p0, f32x16& p1, const u32x4 (&pw)[4], const bf16x8 (&qr)[NKS], const f32x16& negm, lds_cptr kp, lds_cptr vp) {
    typedef Ops<NKS, ND, PV, QK> OP;
    constexpr int AT_D = (ND >= 4) ? 6 : 8;
    s16x4 flo[AT_D], fhi[AT_D];
#define AT_LOAD(i) do { if (OP::kind(i) == 0) { flo[(i) % AT_D] = vtr(vp + OP::a(i) * 4096 + OP::b(i) * 1024); fhi[(i) % AT_D] = vtr(vp + OP::a(i) * 4096 + OP::b(i) * 1024 + 512); } \
        else { const bf16x8 kk_ = *(const LAS bf16x8*)(kp + OP::a(i) * 2048 + OP::b(i) * 512); flo[(i) % AT_D] = (s16x4){kk_[0], kk_[1], kk_[2], kk_[3]}; fhi[(i) % AT_D] = (s16x4){kk_[4], kk_[5], kk_[6], kk_[7]}; } } while (0)
#pragma unroll
    for (int i = 0; i < AT_D && i < OP::N; ++i) AT_LOAD(i);
    __builtin_amdgcn_sched_barrier(0);
#pragma unroll
    for (int i = 0; i < OP::N; ++i) {
        const s16x4 lo = flo[i % AT_D], hh = fhi[i % AT_D];
        const bf16x8 f = (bf16x8){lo[0], lo[1], lo[2], lo[3], hh[0], hh[1], hh[2], hh[3]};
        if (OP::kind(i) == 0) o[OP::a(i)] = __builtin_amdgcn_mfma_f32_32x32x16_bf16(__builtin_bit_cast(bf16x8, pw[OP::b(i)]), f, o[OP::a(i)], 0, 0, 0);
        else if (OP::b(i) == 0) p0 = (OP::a(i) == 0) ? __builtin_amdgcn_mfma_f32_32x32x16_bf16(f, qr[0], negm, 0, 0, 0) : __builtin_amdgcn_mfma_f32_32x32x16_bf16(f, qr[OP::a(i)], p0, 0, 0, 0);
        else p1 = (OP::a(i) == 0) ? __builtin_amdgcn_mfma_f32_32x32x16_bf16(f, qr[0], negm, 0, 0, 0) : __builtin_amdgcn_mfma_f32_32x32x16_bf16(f, qr[OP::a(i)], p1, 0, 0, 0);
        if (i + AT_D < OP::N) AT_LOAD(i + AT_D);
        __builtin_amdgcn_sched_barrier(0);
    }

#undef AT_LOAD
}

template <int NKS, int ND, bool MLA>
__device__ __forceinline__ void attn_unit(const UnitP& P, LAS unsigned char* lds, const float* __restrict__ rope, const float* __restrict__ gq) {
    typedef Cfg<NKS, ND> C;
    int tid = threadIdx.x; asm volatile("" : "+v"(tid));
    const int lane = tid & 63, r32 = lane & 31, hi = lane >> 5; const int wid = __builtin_amdgcn_readfirstlane(tid >> 6);
    const int grp = wid >> 2, q0 = P.qb * 256, NT = 4 * P.qb + 4, tmax = 4 * P.qb + (wid >> 1);
    bf16x8 qr[NKS];
    { const bf16_t* Qw = P.Q + (size_t)(P.rowbase + q0 + wid * 32 + r32) * P.ldq + hi * 8;
      if constexpr (MLA) {
        float qf[NKS][8]; float ss = 0.f;
#pragma unroll
        for (int d0 = 0; d0 < NKS; ++d0) { const bf16x8 raw = *(const bf16x8*)(Qw + d0 * 16);
#pragma unroll
            for (int j = 0; j < 8; ++j) { qf[d0][j] = bf2f(raw[j]); ss += qf[d0][j] * qf[d0][j]; } }
        ss += __shfl_xor(ss, 32);
        const float r = rsqrtf(ss * (1.0f / 96.0f) + EPS);
#pragma unroll
        for (int d0 = 0; d0 < NKS; ++d0) { const f32x4 g0 = *(const f32x4*)(gq + 16 * d0 + 8 * hi), g1 = *(const f32x4*)(gq + 16 * d0 + 8 * hi + 4);
#pragma unroll
            for (int j = 0; j < 4; ++j) { qf[d0][j] *= r * g0[j]; qf[d0][4 + j] *= r * g1[j]; } }
        const int pos = q0 + wid * 32 + r32; const float* rp = rope + (size_t)pos * 32 + 8 * hi;
        const f32x4 c0 = *(const f32x4*)rp, c1 = *(const f32x4*)(rp + 4), s0 = *(const f32x4*)(rp + 16), s1 = *(const f32x4*)(rp + 20);
#pragma unroll
        for (int j = 0; j < 8; ++j) { const float c = j < 4 ? c0[j & 3] : c1[j & 3], s = j < 4 ? s0[j & 3] : s1[j & 3]; const float a = qf[4][j], b = qf[5][j]; qf[4][j] = a * c - b * s; qf[5][j] = b * c + a * s; }
        const float sc = 0.10206207261596577f * LOG2E;
#pragma unroll
        for (int d0 = 0; d0 < NKS; ++d0) { u32x4 w; w.x = cvtpk(qf[d0][0] * sc, qf[d0][1] * sc); w.y = cvtpk(qf[d0][2] * sc, qf[d0][3] * sc); w.z = cvtpk(qf[d0][4] * sc, qf[d0][5] * sc); w.w = cvtpk(qf[d0][6] * sc, qf[d0][7] * sc);
            qr[d0] = __builtin_bit_cast(bf16x8, w); }
      } else {
#pragma unroll
        for (int d0 = 0; d0 < NKS; ++d0) qr[d0] = *(const bf16x8*)(Qw + d0 * 16);
      } }
    LAS float* wsf = (LAS float*)(lds + C::LDS_WS) + wid * 64;
    const bool fixed_ref = __builtin_amdgcn_readfirstlane(__float_as_int(*P.bound)) < __float_as_int(64.0f) && *P.bound >= 0.f;
    if constexpr (!MLA) { LAS float* tb = (LAS float*)(lds + C::LDS_BIAS); tb[tid] = P.btab[tid]; tb[tid + 512] = P.btab[tid + 512]; }
    asm volatile("s_waitcnt vmcnt(0)" ::: "memory");
    const unsigned lds0 = (unsigned)(size_t)lds;
    const bf16_t* kbase = P.K; const bf16_t* vbase = P.V;
    const unsigned koff0 = (unsigned)(wid * 1024 + lane * 16), koff1 = (unsigned)((8 + (wid & 3)) * 1024 + lane * 16);
    const unsigned kdst0 = lds0 + C::LDS_K + wid * 1024, kdst1 = lds0 + C::LDS_K + (8 + (wid & 3)) * 1024;
    const unsigned voff0 = (unsigned)(wid * 1024 + lane * 16), voff1 = voff0 + 8192u;
    const unsigned vdst0 = lds0 + C::LDS_V + wid * 1024, vdst1 = vdst0 + 8192;
    const size_t ktile = (size_t)C::KSLOT / 2, vtile = (size_t)C::VSLOT / 2;
#define DMA_K(t, slotoff) do { const bf16_t* kb_ = kbase + (size_t)(t) * ktile; glds16(kb_, koff0, (unsigned)__builtin_amdgcn_readfirstlane(kdst0 + (slotoff))); \
        if constexpr (C::NKD == 2) { if (grp == 0) glds16(kb_, koff1, (unsigned)__builtin_amdgcn_readfirstlane(kdst1 + (slotoff))); } } while (0)
#define DMA_V(t, slotoff) do { const bf16_t* vb_ = vbase + (size_t)(t) * vtile; glds16(vb_, voff0, (unsigned)__builtin_amdgcn_readfirstlane(vdst0 + (slotoff))); \
        if constexpr (C::NVD == 2) glds16(vb_, voff1, (unsigned)__builtin_amdgcn_readfirstlane(vdst1 + (slotoff))); } while (0)
    const lds_cptr kp0 = (lds_cptr)lds + C::LDS_K + hi * 1024 + r32 * 16;
    const lds_cptr vp0 = (lds_cptr)lds + C::LDS_V + ((lane >> 4) & 1) * 32 + (lane & 3) * 8 + (4 * hi + ((lane & 15) >> 2)) * 64;
    DMA_K(0, 0); DMA_K(1, C::KSLOT); DMA_V(0, 0);
    static_assert(C::NDMA == 3, "three LDS-DMA pieces per wave per tile");
    if (C::NKD == 2 && grp == 1) { AT_WAITBAR(2); } else { AT_WAITBAR(3); }
    float mhat = 0.f, l_reg = 0.f; f32x16 o[ND]; f32x16 negm = f32x16{}; f32x16 p0 = f32x16{}, p1 = f32x16{}; u32x4 pw[4];
#pragma unroll
    for (int d = 0; d < ND; ++d) o[d] = f32x16{};
#pragma unroll
    for (int k = 0; k < 4; ++k) pw[k] = (u32x4){0u, 0u, 0u, 0u};
#if defined(PROBE_MFMA2)
    f32x16 od_[ND], dp0_ = f32x16{}, dp1_ = f32x16{};
#pragma unroll
    for (int d = 0; d < ND; ++d) od_[d] = f32x16{};
#endif
    int ks0 = 0, ks1 = C::KSLOT, ks2 = 2 * C::KSLOT;
    int vsm = 2 * C::VSLOT, vs0 = 0, vs1 = C::VSLOT;
    if (grp == 1) AT_BAR();
    for (int t = 0; t <= NT; ++t) {
        const bool gk = t + 2 < NT, gv = t + 1 < NT;
        { const bool do_pv = (t >= 1 && t - 1 <= tmax), do_qk = (t < NT && t <= tmax);
          const lds_cptr vp = vp0 + vsm, kp = kp0 + ks0;
          if (do_pv && do_qk) mfma_slot<NKS, ND, true, true>(o, p0, p1, pw, qr, negm, kp, vp);
          else if (do_qk) mfma_slot<NKS, ND, false, true>(o, p0, p1, pw, qr, negm, kp, vp);
          else if (do_pv) mfma_slot<NKS, ND, true, false>(o, p0, p1, pw, qr, negm, kp, vp); }
#if defined(PROBE_MFMA2)
        if constexpr (MLA) { const bool do_pv = (t >= 1 && t - 1 <= tmax), do_qk = (t < NT && t <= tmax); const lds_cptr vp = vp0 + vsm, kp = kp0 + ks0;
          if (do_pv && do_qk) { mfma_slot<NKS, ND, true, true>(od_, dp0_, dp1_, pw, qr, negm, kp, vp); asm volatile("" :: "v"(od_[0]), "v"(od_[1]), "v"(dp0_), "v"(dp1_)); } }
#endif
        if (t == NT) break;
        const int cnt = (gk ? C::NKD : 0) + (gv ? C::NVD : 0);
#define AT_CLOSE() do { if (cnt == 3) { AT_WAITBAR(3); } else if (cnt == 2) { AT_WAITBAR(2); } else if (cnt == 1) { AT_WAITBAR(1); } else { AT_WAITBAR(0); } } while (0)
        if (grp == 1) { AT_WAITBAR(0); } else AT_BAR();
        if (gk) DMA_K(t + 2, ks2);
        if (gv) DMA_V(t + 1, vs1);
        if (t <= tmax) {
            if constexpr (!MLA) {
                const int dmin = q0 + wid * 32 - 64 * t - 63;
                if (dmin < 559) { const LAS float* tb = (const LAS float*)(lds + C::LDS_BIAS) + (dmin + r32 + 63 + 63 - 4 * hi);
#pragma unroll
                    for (int r = 0; r < 16; ++r) { const int kk = (r & 3) + 8 * (r >> 2); p0[r] += tb[-kk]; p1[r] += tb[-kk - 32]; } }
            }
            if (!fixed_ref) {
            float a = fmaxf(fmaxf(p0[0], p0[1]), p1[0]), b = fmaxf(fmaxf(p0[2], p0[3]), p1[1]); a = fmaxf(fmaxf(a, p1[2]), p1[3]);
#pragma unroll
            for (int r = 4; r < 16; r += 4) { a = fmaxf(fmaxf(a, p0[r]), p0[r + 1]); b = fmaxf(fmaxf(b, p0[r + 2]), p0[r + 3]); a = fmaxf(fmaxf(a, p1[r]), p1[r + 1]); b = fmaxf(fmaxf(b, p1[r + 2]), p1[r + 3]); }
            float rm = fmaxf(a, b); { auto rr = __builtin_amdgcn_permlane32_swap(__float_as_uint(rm), __float_as_uint(rm), false, false); rm = fmaxf(__uint_as_float(rr[0]), __uint_as_float(rr[1])); }
            if (t == 0 || __any(rm > THR)) {
                const float dl = (t == 0) ? rm : fmaxf(rm, 0.f); mhat += dl;
#pragma unroll
                for (int r = 0; r < 16; ++r) { p0[r] -= dl; p1[r] -= dl; }
#pragma unroll
                for (int r = 0; r < 16; ++r) negm[r] = -mhat;
                if (t != 0) { const float f = __builtin_amdgcn_exp2f(-dl); l_reg *= f; if (hi == 0) wsf[r32] = f;
                    asm volatile("s_waitcnt lgkmcnt(0)" ::: "memory");
#pragma unroll
                    for (int r = 0; r < 16; ++r) { const float fr_ = wsf[crow(r, hi)];
#pragma unroll
                        for (int d = 0; d < ND; ++d) o[d][r] *= fr_; } }
            }
            }
            float sacc = 0.f;
#pragma unroll
            for (int r = 0; r < 16; ++r) { p0[r] = __builtin_amdgcn_exp2f(p0[r]); p1[r] = __builtin_amdgcn_exp2f(p1[r]); sacc += p0[r] + p1[r]; }
            l_reg += sacc;
#if defined(PROBE_SM2)
            if constexpr (MLA) { float dsum_ = 0.f;
#pragma unroll
                for (int r = 0; r < 16; ++r) { dsum_ += __builtin_amdgcn_exp2f(p0[r] - 1.0f) + __builtin_amdgcn_exp2f(p1[r] - 1.0f); }
                asm volatile("" :: "v"(dsum_)); }
#endif
            pw[0] = (u32x4){cvtpk(p0[0], p0[1]), cvtpk(p0[2], p0[3]), cvtpk(p0[4], p0[5]), cvtpk(p0[6], p0[7])};
            pw[1] = (u32x4){cvtpk(p0[8], p0[9]), cvtpk(p0[10], p0[11]), cvtpk(p0[12], p0[13]), cvtpk(p0[14], p0[15])};
            pw[2] = (u32x4){cvtpk(p1[0], p1[1]), cvtpk(p1[2], p1[3]), cvtpk(p1[4], p1[5]), cvtpk(p1[6], p1[7])};
            pw[3] = (u32x4){cvtpk(p1[8], p1[9]), cvtpk(p1[10], p1[11]), cvtpk(p1[12], p1[13]), cvtpk(p1[14], p1[15])};
        }
        if (grp == 0) AT_CLOSE(); else AT_BAR();
        { const int k_ = ks0; ks0 = ks1; ks1 = ks2; ks2 = k_; const int v_ = vsm; vsm = vs0; vs0 = vs1; vs1 = v_; }
    }
    if (grp == 0) AT_BAR();
    unsigned nx_ = 0u; if (P.qhead != nullptr && wid == 0 && lane == 0) nx_ = __hip_atomic_fetch_add(P.qhead, 1u, __ATOMIC_RELAXED, __HIP_MEMORY_SCOPE_AGENT) + P.qbase;
    { auto rr = __builtin_amdgcn_permlane32_swap(__float_as_uint(l_reg), __float_as_uint(l_reg), false, false); l_reg = __uint_as_float(rr[0]) + __uint_as_float(rr[1]); }
    if (hi == 0) wsf[32 + r32] = l_reg;
    asm volatile("s_waitcnt lgkmcnt(0)" ::: "memory");
    { int le = lane; asm volatile("" : "+v"(le));
      const int r32e = le & 31, hie = le >> 5;
      LAS bf16_t* stg = (LAS bf16_t*)(lds + C::LDS_OST + wid * C::OSTW);
      constexpr int RW = ND * 32;
#pragma unroll
      for (int r = 0; r < 16; ++r) { const int orow = (r & 3) + 8 * (r >> 2); const float rl = __builtin_amdgcn_rcpf(wsf[32 + 4 * hie + orow]);
#pragma unroll
          for (int d0 = 0; d0 < ND; ++d0) { const unsigned w = cvtpk(o[d0][r] * rl, 0.f); stg[(4 * hie + r32e) + orow * RW + d0 * 32 + (RW - 1) * 4 * hie] = (bf16_t)(w & 0xffffu); } }
      asm volatile("s_waitcnt lgkmcnt(0)" ::: "memory");
      constexpr int CPR = ND * 4, RPI = 64 / CPR;
      const int rowl = le / CPR, ch = le % CPR;
      const LAS bf16_t* sp = stg + rowl * RW + ch * 8;
      bf16_t* Ow = P.O + (size_t)(P.rowbase + q0 + wid * 32 + rowl) * P.ldo + ch * 8;
      if (MLA || P.O1 == nullptr) {
#pragma unroll
          for (int i = 0; i < ND * 2; ++i) { const u32x4 v = *(const LAS u32x4*)(sp + i * RPI * RW); *(u32x4*)(Ow + (size_t)(i * RPI) * P.ldo) = v; }
      } else {
          const float lam = *P.lamp; const f32x4 g0 = *(const f32x4*)(P.gout + ch * 8) * 0.8f, g1 = *(const f32x4*)(P.gout + ch * 8 + 4) * 0.8f;
          const bf16_t* O1p = P.O1 + (size_t)(P.rowbase + q0 + wid * 32 + rowl) * 1024 + ch * 8; bf16_t* Yp = P.Yc + (size_t)(P.rowbase + q0 + wid * 32 + rowl) * 1024 + ch * 8;
#pragma unroll
          for (int i = 0; i < ND * 2; ++i) { const u32x4 v2 = *(const LAS u32x4*)(sp + i * RPI * RW); const u32x4 v1 = *(const u32x4*)(O1p + (size_t)(i * RPI) * 1024);
              f32x4 a = (f32x4){bflo(v1.x) - lam * bflo(v2.x), bfhi(v1.x) - lam * bfhi(v2.x), bflo(v1.y) - lam * bflo(v2.y), bfhi(v1.y) - lam * bfhi(v2.y)};
              f32x4 b = (f32x4){bflo(v1.z) - lam * bflo(v2.z), bfhi(v1.z) - lam * bfhi(v2.z), bflo(v1.w) - lam * bflo(v2.w), bfhi(v1.w) - lam * bfhi(v2.w)};
              float ss = sq4(a) + sq4(b); ss += __shfl_xor(ss, 1); ss += __shfl_xor(ss, 2); ss += __shfl_xor(ss, 4); ss += __shfl_xor(ss, 8);
              const float r = rsqrtf(ss * (1.0f / 128.0f) + EPS);
              *(u32x4*)(Yp + (size_t)(i * RPI) * 1024) = pack8(a * g0 * r, b * g1 * r); }
      } }
    if (P.qhead != nullptr && wid == 0 && lane == 0) *P.qw = nx_;
    AT_BAR();
#undef DMA_K
#undef DMA_V
#undef AT_CLOSE
}

template <int NKS, int ND, bool MLA>
__device__ __forceinline__ void attn_unit_iw(const UnitP& P, LAS unsigned char* lds, const float* __restrict__ rope, const float* __restrict__ gq) {
    typedef Cfg<NKS, ND, 4> C;
    int tid = threadIdx.x; asm volatile("" : "+v"(tid));
    const int lane = tid & 63, r32 = lane & 31, hi = lane >> 5; const int wid = __builtin_amdgcn_readfirstlane(tid >> 6);
    const int grp = wid >> 2, q0 = P.qb * 256, NT = 4 * P.qb + 4, tmax = 4 * P.qb + (wid >> 1);
    bf16x8 qr[NKS];
    { const bf16_t* Qw = P.Q + (size_t)(P.rowbase + q0 + wid * 32 + r32) * P.ldq + hi * 8;
      if constexpr (MLA) {
        float qf[NKS][8]; float ss = 0.f;
#pragma unroll
        for (int d0 = 0; d0 < NKS; ++d0) { const bf16x8 raw = *(const bf16x8*)(Qw + d0 * 16);
#pragma unroll
            for (int j = 0; j < 8; ++j) { qf[d0][j] = bf2f(raw[j]); ss += qf[d0][j] * qf[d0][j]; } }
        ss += __shfl_xor(ss, 32);
        const float r = rsqrtf(ss * (1.0f / 96.0f) + EPS);
#pragma unroll
        for (int d0 = 0; d0 < NKS; ++d0) { const f32x4 g0 = *(const f32x4*)(gq + 16 * d0 + 8 * hi), g1 = *(const f32x4*)(gq + 16 * d0 + 8 * hi + 4);
#pragma unroll
            for (int j = 0; j < 4; ++j) { qf[d0][j] *= r * g0[j]; qf[d0][4 + j] *= r * g1[j]; } }
        const int pos = q0 + wid * 32 + r32; const float* rp = rope + (size_t)pos * 32 + 8 * hi;
        const f32x4 c0 = *(const f32x4*)rp, c1 = *(const f32x4*)(rp + 4), s0 = *(const f32x4*)(rp + 16), s1 = *(const f32x4*)(rp + 20);
#pragma unroll
        for (int j = 0; j < 8; ++j) { const float c = j < 4 ? c0[j & 3] : c1[j & 3], s = j < 4 ? s0[j & 3] : s1[j & 3]; const float a = qf[4][j], b = qf[5][j]; qf[4][j] = a * c - b * s; qf[5][j] = b * c + a * s; }
        const float sc = 0.10206207261596577f * LOG2E;
#pragma unroll
        for (int d0 = 0; d0 < NKS; ++d0) { u32x4 w; w.x = cvtpk(qf[d0][0] * sc, qf[d0][1] * sc); w.y = cvtpk(qf[d0][2] * sc, qf[d0][3] * sc); w.z = cvtpk(qf[d0][4] * sc, qf[d0][5] * sc); w.w = cvtpk(qf[d0][6] * sc, qf[d0][7] * sc);
            qr[d0] = __builtin_bit_cast(bf16x8, w); }
      } else {
#pragma unroll
        for (int d0 = 0; d0 < NKS; ++d0) qr[d0] = *(const bf16x8*)(Qw + d0 * 16);
      } }
    LAS float* wsf = (LAS float*)(lds + C::LDS_WS) + wid * 64;
    const bool fixed_ref = __builtin_amdgcn_readfirstlane(__float_as_int(*P.bound)) < __float_as_int(64.0f) && *P.bound >= 0.f;
    if constexpr (!MLA) { LAS float* tb = (LAS float*)(lds + C::LDS_BIAS); tb[tid] = P.btab[tid]; tb[tid + 512] = P.btab[tid + 512]; }
    asm volatile("s_waitcnt vmcnt(0)" ::: "memory");
    const unsigned lds0 = (unsigned)(size_t)lds;
    const bf16_t* kbase = P.K; const bf16_t* vbase = P.V;
    const unsigned koff0 = (unsigned)(wid * 1024 + lane * 16), koff1 = (unsigned)((8 + (wid & 3)) * 1024 + lane * 16);
    const unsigned kdst0 = lds0 + C::LDS_K + wid * 1024, kdst1 = lds0 + C::LDS_K + (8 + (wid & 3)) * 1024;
    const unsigned voff0 = (unsigned)(wid * 1024 + lane * 16), voff1 = voff0 + 8192u;
    const unsigned vdst0 = lds0 + C::LDS_V + wid * 1024, vdst1 = vdst0 + 8192;
    const size_t ktile = (size_t)C::KSLOT / 2, vtile = (size_t)C::VSLOT / 2;
#define DMA_K(t, slotoff) do { const bf16_t* kb_ = kbase + (size_t)(t) * ktile; glds16(kb_, koff0, (unsigned)__builtin_amdgcn_readfirstlane(kdst0 + (slotoff))); \
        if constexpr (C::NKD == 2) glds16(kb_, koff1, (unsigned)__builtin_amdgcn_readfirstlane(kdst1 + (slotoff))); } while (0)
#define DMA_V(t, slotoff) do { const bf16_t* vb_ = vbase + (size_t)(t) * vtile; glds16(vb_, voff0, (unsigned)__builtin_amdgcn_readfirstlane(vdst0 + (slotoff))); \
        if constexpr (C::NVD == 2) glds16(vb_, voff1, (unsigned)__builtin_amdgcn_readfirstlane(vdst1 + (slotoff))); } while (0)
    const lds_cptr kp0 = (lds_cptr)lds + C::LDS_K + hi * 1024 + r32 * 16;
    const lds_cptr vp0 = (lds_cptr)lds + C::LDS_V + ((lane >> 4) & 1) * 32 + (lane & 3) * 8 + (4 * hi + ((lane & 15) >> 2)) * 64;
    DMA_K(0, 0); DMA_K(1, C::KSLOT); DMA_K(2, 2 * C::KSLOT); DMA_V(0, 0);
    static_assert(C::NDMA == 3, "three LDS-DMA pieces per wave per tile");
    AT_WAITBAR(3);
    float l_reg = 0.f; f32x16 o[ND]; f32x16 pA0, pA1, pB0, pB1; u32x4 pw[4];
#pragma unroll
    for (int d = 0; d < ND; ++d) o[d] = f32x16{};
#pragma unroll
    for (int k = 0; k < 4; ++k) pw[k] = (u32x4){0u, 0u, 0u, 0u};
    int ks0 = 0, ks1 = C::KSLOT, ks2 = 2 * C::KSLOT, ks3 = 3 * C::KSLOT;
    s16x4 flo[(ND >= 4) ? 6 : 8], fhi[(ND >= 4) ? 6 : 8];
    int vsm = 2 * C::VSLOT, vs0 = 0, vs1 = C::VSLOT;
    (void)grp; (void)fixed_ref; (void)wsf;
    constexpr int NQK = 2 * NKS, NPV = 4 * ND, NOPS = NQK + NPV, WD = 6;
    constexpr int FA = (32 + NQK - 1) / NQK, FP = (16 + NQK - 1) / NQK, FE = 32 / NPV;
    static_assert(32 % NPV == 0, "exps split evenly over the P.V gaps");
#define PE(P0_, P1_, e_) (((e_) < 16) ? P0_[(e_) & 15] : P1_[(e_) & 15])
#define W_LOAD(i_) do { if ((i_) < NQK) { const bf16x8 kk_ = *(const LAS bf16x8*)(kp_ + ((i_) / 2) * 2048 + ((i_) % 2) * 512); flo[(i_) % WD] = (s16x4){kk_[0], kk_[1], kk_[2], kk_[3]}; fhi[(i_) % WD] = (s16x4){kk_[4], kk_[5], kk_[6], kk_[7]}; } \
        else { flo[(i_) % WD] = vtr(vp_ + (((i_) - NQK) / 4) * 4096 + (((i_) - NQK) % 4) * 1024); fhi[(i_) % WD] = vtr(vp_ + (((i_) - NQK) / 4) * 4096 + (((i_) - NQK) % 4) * 1024 + 512); } } while (0)
#define W_FRAG(i_) ((bf16x8){flo[(i_) % WD][0], flo[(i_) % WD][1], flo[(i_) % WD][2], flo[(i_) % WD][3], fhi[(i_) % WD][0], fhi[(i_) % WD][1], fhi[(i_) % WD][2], fhi[(i_) % WD][3]})
#define ISSUE_DMA(t_) do { if ((t_) + 3 < NT) DMA_K((t_) + 3, ks3); if ((t_) + 1 < NT) DMA_V((t_) + 1, vs1); } while (0)
#define PREFILL(t_) do { if ((t_) + 1 <= tmax) { const lds_cptr kn_ = kp0 + ks1; _Pragma("unroll") for (int i = 0; i < WD; ++i) { const bf16x8 kk_ = *(const LAS bf16x8*)(kn_ + (i / 2) * 2048 + (i % 2) * 512); flo[i] = (s16x4){kk_[0], kk_[1], kk_[2], kk_[3]}; fhi[i] = (s16x4){kk_[4], kk_[5], kk_[6], kk_[7]}; } } } while (0)
#define BIAS(C0_, C1_, t_) do { if constexpr (!MLA) { const int dmin_ = q0 + wid * 32 - 64 * (t_) - 63; \
        if (dmin_ < 559) { const LAS float* tb_ = (const LAS float*)(lds + C::LDS_BIAS) + (dmin_ + r32 + 126 - 4 * hi); \
            _Pragma("unroll") for (int r = 0; r < 16; ++r) { const int kk_ = (r & 3) + 8 * (r >> 2); C0_[r] += tb_[-kk_]; C1_[r] += tb_[-kk_ - 32]; } } } } while (0)
#define SUMPACK_ALL(P0_, P1_) do { float sa_ = 0.f; _Pragma("unroll") for (int e = 0; e < 32; ++e) sa_ += PE(P0_, P1_, e); l_reg += sa_; \
        _Pragma("unroll") for (int w = 0; w < 16; ++w) pw[w / 4][w % 4] = cvtpk(PE(P0_, P1_, 2 * w), PE(P0_, P1_, 2 * w + 1)); } while (0)
#define STEP(C0_, C1_, P0_, P1_, t_) do { \
        const lds_cptr kp_ = kp0 + ks0, vp_ = vp0 + vsm; \
        __builtin_amdgcn_sched_barrier(0); \
        float sacc_ = 0.f; \
        _Pragma("unroll") for (int g = 0; g < NQK; ++g) { const bf16x8 f_ = W_FRAG(g); \
            if ((g & 1) == 0) C0_ = (g / 2 == 0) ? __builtin_amdgcn_mfma_f32_32x32x16_bf16(f_, qr[0], (f32x16){}, 0, 0, 0) : __builtin_amdgcn_mfma_f32_32x32x16_bf16(f_, qr[g / 2], C0_, 0, 0, 0); \
            else C1_ = (g / 2 == 0) ? __builtin_amdgcn_mfma_f32_32x32x16_bf16(f_, qr[0], (f32x16){}, 0, 0, 0) : __builtin_amdgcn_mfma_f32_32x32x16_bf16(f_, qr[g / 2], C1_, 0, 0, 0); \
            if (g + WD < NOPS) W_LOAD(g + WD); \
            _Pragma("unroll") for (int j = 0; j < FA; ++j) { if (g * FA + j < 32) sacc_ += PE(P0_, P1_, (g * FA + j) & 31); } \
            _Pragma("unroll") for (int j = 0; j < FP; ++j) { if (g * FP + j < 16) { unsigned pk_ = cvtpk(PE(P0_, P1_, (2 * (g * FP + j)) & 31), PE(P0_, P1_, (2 * (g * FP + j) + 1) & 31)); asm volatile("" : "+v"(pk_)); pw[((g * FP + j) & 15) / 4][(g * FP + j) % 4] = pk_; } } \
            asm volatile("" : "+v"(sacc_)); \
            if (g == 1) { if ((t_) + 3 < NT) DMA_K((t_) + 3, ks3); } \
            if (g == 5) { if ((t_) + 1 < NT) DMA_V((t_) + 1, vs1); } \
            __builtin_amdgcn_sched_barrier(0); } \
        l_reg += sacc_; \
        BIAS(C0_, C1_, t_); \
        __builtin_amdgcn_sched_barrier(0); \
        _Pragma("unroll") for (int h = 0; h < NPV; ++h) { const bf16x8 f_ = W_FRAG(NQK + h); \
            o[h / 4] = __builtin_amdgcn_mfma_f32_32x32x16_bf16(__builtin_bit_cast(bf16x8, pw[h % 4]), f_, o[h / 4], 0, 0, 0); \
            if (NQK + h + WD < NOPS) W_LOAD(NQK + h + WD); \
            _Pragma("unroll") for (int j = 0; j < FE; ++j) { if (h * FE + j < 16) C0_[(h * FE + j) & 15] = __builtin_amdgcn_exp2f(C0_[(h * FE + j) & 15]); else C1_[(h * FE + j) & 15] = __builtin_amdgcn_exp2f(C1_[(h * FE + j) & 15]); } \
            if (h * FE < 16) asm volatile("" : "+v"(C0_)); else asm volatile("" : "+v"(C1_)); \
            __builtin_amdgcn_sched_barrier(0); } \
        PREFILL(t_); \
    } while (0)
#define DRAIN(P0_, P1_) do { SUMPACK_ALL(P0_, P1_); f32x16 d0_ = f32x16{}, d1_ = f32x16{}; const f32x16 z_ = f32x16{}; mfma_slot<NKS, ND, true, false>(o, d0_, d1_, pw, qr, z_, kp0 + ks0, vp0 + vsm); } while (0)
#define AT_CLOSE(t_) do { const int cnt_ = (((t_) + 3 < NT) ? C::NKD : 0) + (((t_) + 1 < NT) ? C::NVD : 0); \
        if (cnt_ == 3) { AT_WAITBAR_NL(3); } else if (cnt_ == 2) { AT_WAITBAR_NL(2); } else if (cnt_ == 1) { AT_WAITBAR_NL(1); } else { AT_WAITBAR_NL(0); } } while (0)
#define ROTATE() do { const int k_ = ks0; ks0 = ks1; ks1 = ks2; ks2 = ks3; ks3 = k_; const int v_ = vsm; vsm = vs0; vs0 = vs1; vs1 = v_; } while (0)
#define SLOT(C0_, C1_, P0_, P1_, t_) do { if ((t_) <= tmax) { STEP(C0_, C1_, P0_, P1_, t_); } else { ISSUE_DMA(t_); if ((t_) == tmax + 1) { DRAIN(P0_, P1_); } } AT_CLOSE(t_); ROTATE(); } while (0)
    { ISSUE_DMA(0);
      const f32x16 z_ = f32x16{};
      mfma_slot<NKS, ND, false, true>(o, pA0, pA1, pw, qr, z_, kp0 + ks0, vp0 + vsm);
      BIAS(pA0, pA1, 0);
#pragma unroll
      for (int r = 0; r < 16; ++r) { pA0[r] = __builtin_amdgcn_exp2f(pA0[r]); pA1[r] = __builtin_amdgcn_exp2f(pA1[r]); }
      PREFILL(0);
      AT_CLOSE(0); ROTATE(); }
    int t = 1; const int tlast = tmax < NT - 1 ? tmax : NT - 1;
#pragma unroll 1
    for (; t + 1 <= tlast; t += 2) {
        STEP(pB0, pB1, pA0, pA1, t); AT_CLOSE(t); ROTATE();
        STEP(pA0, pA1, pB0, pB1, t + 1); AT_CLOSE(t + 1); ROTATE();
    }
    if (t <= tlast) { STEP(pB0, pB1, pA0, pA1, t); AT_CLOSE(t); ROTATE(); pA0 = pB0; pA1 = pB1; ++t; }
    if (t < NT) { ISSUE_DMA(t); DRAIN(pA0, pA1); AT_CLOSE(t); ROTATE(); ++t; }
#pragma unroll 1
    for (; t < NT; ++t) { ISSUE_DMA(t); AT_CLOSE(t); ROTATE(); }
    if (tmax == NT - 1) { DRAIN(pA0, pA1); }
#undef PE
#undef W_LOAD
#undef W_FRAG
#undef ISSUE_DMA
#undef PREFILL
#undef BIAS
#undef SUMPACK_ALL
#undef STEP
#undef DRAIN
#undef ROTATE
#undef SLOT
    unsigned nx_ = 0u; if (P.qhead != nullptr && wid == 0 && lane == 0) nx_ = __hip_atomic_fetch_add(P.qhead, 1u, __ATOMIC_RELAXED, __HIP_MEMORY_SCOPE_AGENT) + P.qbase;
    { auto rr = __builtin_amdgcn_permlane32_swap(__float_as_uint(l_reg), __float_as_uint(l_reg), false, false); l_reg = __uint_as_float(rr[0]) + __uint_as_float(rr[1]); }
    if (hi == 0) wsf[32 + r32] = l_reg;
    asm volatile("s_waitcnt lgkmcnt(0)" ::: "memory");
    { int le = lane; asm volatile("" : "+v"(le));
      const int r32e = le & 31, hie = le >> 5;
      LAS bf16_t* stg = (LAS bf16_t*)(lds + C::LDS_OST + wid * C::OSTW);
      constexpr int RW = ND * 32;
#pragma unroll
      for (int r = 0; r < 16; ++r) { const int orow = (r & 3) + 8 * (r >> 2); const float rl = __builtin_amdgcn_rcpf(wsf[32 + 4 * hie + orow]);
#pragma unroll
          for (int d0 = 0; d0 < ND; ++d0) { const unsigned w = cvtpk(o[d0][r] * rl, 0.f); stg[(4 * hie + r32e) + orow * RW + d0 * 32 + (RW - 1) * 4 * hie] = (bf16_t)(w & 0xffffu); } }
      asm volatile("s_waitcnt lgkmcnt(0)" ::: "memory");
      constexpr int CPR = ND * 4, RPI = 64 / CPR;
      const int rowl = le / CPR, ch = le % CPR;
      const LAS bf16_t* sp = stg + rowl * RW + ch * 8;
      bf16_t* Ow = P.O + (size_t)(P.rowbase + q0 + wid * 32 + rowl) * P.ldo + ch * 8;
      if (MLA || P.O1 == nullptr) {
#pragma unroll
          for (int i = 0; i < ND * 2; ++i) { const u32x4 v = *(const LAS u32x4*)(sp + i * RPI * RW); *(u32x4*)(Ow + (size_t)(i * RPI) * P.ldo) = v; }
      } else {
          const float lam = *P.lamp; const f32x4 g0 = *(const f32x4*)(P.gout + ch * 8) * 0.8f, g1 = *(const f32x4*)(P.gout + ch * 8 + 4) * 0.8f;
          const bf16_t* O1p = P.O1 + (size_t)(P.rowbase + q0 + wid * 32 + rowl) * 1024 + ch * 8; bf16_t* Yp = P.Yc + (size_t)(P.rowbase + q0 + wid * 32 + rowl) * 1024 + ch * 8;
#pragma unroll
          for (int i = 0; i < ND * 2; ++i) { const u32x4 v2 = *(const LAS u32x4*)(sp + i * RPI * RW); const u32x4 v1 = *(const u32x4*)(O1p + (size_t)(i * RPI) * 1024);
              f32x4 a = (f32x4){bflo(v1.x) - lam * bflo(v2.x), bfhi(v1.x) - lam * bfhi(v2.x), bflo(v1.y) - lam * bflo(v2.y), bfhi(v1.y) - lam * bfhi(v2.y)};
              f32x4 b = (f32x4){bflo(v1.z) - lam * bflo(v2.z), bfhi(v1.z) - lam * bfhi(v2.z), bflo(v1.w) - lam * bflo(v2.w), bfhi(v1.w) - lam * bfhi(v2.w)};
              float ss = sq4(a) + sq4(b); ss += __shfl_xor(ss, 1); ss += __shfl_xor(ss, 2); ss += __shfl_xor(ss, 4); ss += __shfl_xor(ss, 8);
              const float r = rsqrtf(ss * (1.0f / 128.0f) + EPS);
              *(u32x4*)(Yp + (size_t)(i * RPI) * 1024) = pack8(a * g0 * r, b * g1 * r); }
      } }
    if (P.qhead != nullptr && wid == 0 && lane == 0) *P.qw = nx_;
    AT_BAR();
#undef DMA_K
#undef DMA_V
#undef AT_CLOSE
}

template <int NKS, int ND, bool MLA>
__device__ __forceinline__ void attn_unit_iw2(const UnitP& P, LAS unsigned char* lds, const float* __restrict__ rope, const float* __restrict__ gq) {
    typedef Cfg<NKS, ND, 4> C;
    int tid = threadIdx.x; asm volatile("" : "+v"(tid));
    const int lane = tid & 63, r32 = lane & 31, hi = lane >> 5; const int wid = __builtin_amdgcn_readfirstlane(tid >> 6);
    const int grp = wid >> 2, q0 = P.qb * 256, NT = 4 * P.qb + 4, tmax = 4 * P.qb + (wid >> 1);
    bf16x8 qr[NKS];
    { const bf16_t* Qw = P.Q + (size_t)(P.rowbase + q0 + wid * 32 + r32) * P.ldq + hi * 8;
      if constexpr (MLA) {
        float qf[NKS][8]; float ss = 0.f;
#pragma unroll
        for (int d0 = 0; d0 < NKS; ++d0) { const bf16x8 raw = *(const bf16x8*)(Qw + d0 * 16);
#pragma unroll
            for (int j = 0; j < 8; ++j) { qf[d0][j] = bf2f(raw[j]); ss += qf[d0][j] * qf[d0][j]; } }
        ss += __shfl_xor(ss, 32);
        const float r = rsqrtf(ss * (1.0f / 96.0f) + EPS);
#pragma unroll
        for (int d0 = 0; d0 < NKS; ++d0) { const f32x4 g0 = *(const f32x4*)(gq + 16 * d0 + 8 * hi), g1 = *(const f32x4*)(gq + 16 * d0 + 8 * hi + 4);
#pragma unroll
            for (int j = 0; j < 4; ++j) { qf[d0][j] *= r * g0[j]; qf[d0][4 + j] *= r * g1[j]; } }
        const int pos = q0 + wid * 32 + r32; const float* rp = rope + (size_t)pos * 32 + 8 * hi;
        const f32x4 c0 = *(const f32x4*)rp, c1 = *(const f32x4*)(rp + 4), s0 = *(const f32x4*)(rp + 16), s1 = *(const f32x4*)(rp + 20);
#pragma unroll
        for (int j = 0; j < 8; ++j) { const float c = j < 4 ? c0[j & 3] : c1[j & 3], s = j < 4 ? s0[j & 3] : s1[j & 3]; const float a = qf[4][j], b = qf[5][j]; qf[4][j] = a * c - b * s; qf[5][j] = b * c + a * s; }
        const float sc = 0.10206207261596577f * LOG2E;
#pragma unroll
        for (int d0 = 0; d0 < NKS; ++d0) { u32x4 w; w.x = cvtpk(qf[d0][0] * sc, qf[d0][1] * sc); w.y = cvtpk(qf[d0][2] * sc, qf[d0][3] * sc); w.z = cvtpk(qf[d0][4] * sc, qf[d0][5] * sc); w.w = cvtpk(qf[d0][6] * sc, qf[d0][7] * sc);
            qr[d0] = __builtin_bit_cast(bf16x8, w); }
      } else {
#pragma unroll
        for (int d0 = 0; d0 < NKS; ++d0) qr[d0] = *(const bf16x8*)(Qw + d0 * 16);
      } }
    LAS float* wsf = (LAS float*)(lds + C::LDS_WS) + wid * 64;
    const bool fixed_ref = __builtin_amdgcn_readfirstlane(__float_as_int(*P.bound)) < __float_as_int(64.0f) && *P.bound >= 0.f;
    if constexpr (!MLA) { LAS float* tb = (LAS float*)(lds + C::LDS_BIAS); tb[tid] = P.btab[tid]; tb[tid + 512] = P.btab[tid + 512]; }
    asm volatile("s_waitcnt vmcnt(0)" ::: "memory");
    const unsigned lds0 = (unsigned)(size_t)lds;
    const bf16_t* kbase = P.K; const bf16_t* vbase = P.V;
    const unsigned koff0 = (unsigned)(wid * 1024 + lane * 16), koff1 = (unsigned)((8 + (wid & 3)) * 1024 + lane * 16);
    const unsigned kdst0 = lds0 + C::LDS_K + wid * 1024, kdst1 = lds0 + C::LDS_K + (8 + (wid & 3)) * 1024;
    const unsigned voff0 = (unsigned)(wid * 1024 + lane * 16), voff1 = voff0 + 8192u;
    const unsigned vdst0 = lds0 + C::LDS_V + wid * 1024, vdst1 = vdst0 + 8192;
    const size_t ktile = (size_t)C::KSLOT / 2, vtile = (size_t)C::VSLOT / 2;
#define DMA_K(t, slotoff) do { const bf16_t* kb_ = kbase + (size_t)(t) * ktile; glds16(kb_, koff0, (unsigned)__builtin_amdgcn_readfirstlane(kdst0 + (slotoff))); \
        if constexpr (C::NKD == 2) glds16(kb_, koff1, (unsigned)__builtin_amdgcn_readfirstlane(kdst1 + (slotoff))); } while (0)
#define DMA_V(t, slotoff) do { const bf16_t* vb_ = vbase + (size_t)(t) * vtile; glds16(vb_, voff0, (unsigned)__builtin_amdgcn_readfirstlane(vdst0 + (slotoff))); \
        if constexpr (C::NVD == 2) glds16(vb_, voff1, (unsigned)__builtin_amdgcn_readfirstlane(vdst1 + (slotoff))); } while (0)
    const lds_cptr kp0 = (lds_cptr)lds + C::LDS_K + hi * 1024 + r32 * 16;
    const lds_cptr vp0 = (lds_cptr)lds + C::LDS_V + ((lane >> 4) & 1) * 32 + (lane & 3) * 8 + (4 * hi + ((lane & 15) >> 2)) * 64;
    DMA_K(0, 0); DMA_K(1, C::KSLOT); DMA_K(2, 2 * C::KSLOT); DMA_V(0, 0);
    static_assert(C::NDMA == 3, "three LDS-DMA pieces per wave per tile");
    AT_WAITBAR(3);
    float l_reg = 0.f; f32x16 o[ND]; f32x16 c0, c1; u32x4 pwc[4], pwn[4];
#pragma unroll
    for (int d = 0; d < ND; ++d) o[d] = f32x16{};
#pragma unroll
    for (int k = 0; k < 4; ++k) { pwc[k] = (u32x4){0u, 0u, 0u, 0u}; pwn[k] = (u32x4){0u, 0u, 0u, 0u}; }
    int ks0 = 0, ks1 = C::KSLOT, ks2 = 2 * C::KSLOT, ks3 = 3 * C::KSLOT;
    s16x4 flo[(ND >= 4) ? 6 : 8], fhi[(ND >= 4) ? 6 : 8];
    int vsm = 2 * C::VSLOT, vs0 = 0, vs1 = C::VSLOT;
    (void)grp; (void)fixed_ref; (void)wsf;
    constexpr int NQK = 2 * NKS, NPV = 4 * ND, NOPS = NQK + NPV, WD = 6;
    static_assert(NPV == 16, "one bf16 pack word per P.V gap");
#define CE(e_) (((e_) < 16) ? c0[(e_) & 15] : c1[(e_) & 15])
#define W_LOAD(i_) do { if ((i_) < NQK) { const bf16x8 kk_ = *(const LAS bf16x8*)(kp_ + ((i_) / 2) * 2048 + ((i_) % 2) * 512); flo[(i_) % WD] = (s16x4){kk_[0], kk_[1], kk_[2], kk_[3]}; fhi[(i_) % WD] = (s16x4){kk_[4], kk_[5], kk_[6], kk_[7]}; } \
        else { flo[(i_) % WD] = vtr(vp_ + (((i_) - NQK) / 4) * 4096 + (((i_) - NQK) % 4) * 1024); fhi[(i_) % WD] = vtr(vp_ + (((i_) - NQK) / 4) * 4096 + (((i_) - NQK) % 4) * 1024 + 512); } } while (0)
#define W_FRAG(i_) ((bf16x8){flo[(i_) % WD][0], flo[(i_) % WD][1], flo[(i_) % WD][2], flo[(i_) % WD][3], fhi[(i_) % WD][0], fhi[(i_) % WD][1], fhi[(i_) % WD][2], fhi[(i_) % WD][3]})
#define ISSUE_DMA(t_) do { if ((t_) + 3 < NT) DMA_K((t_) + 3, ks3); if ((t_) + 1 < NT) DMA_V((t_) + 1, vs1); } while (0)
#define PREFILL(t_) do { if ((t_) + 1 <= tmax) { const lds_cptr kn_ = kp0 + ks1; _Pragma("unroll") for (int i = 0; i < WD; ++i) { const bf16x8 kk_ = *(const LAS bf16x8*)(kn_ + (i / 2) * 2048 + (i % 2) * 512); flo[i] = (s16x4){kk_[0], kk_[1], kk_[2], kk_[3]}; fhi[i] = (s16x4){kk_[4], kk_[5], kk_[6], kk_[7]}; } } } while (0)
#define BIAS(t_) do { if constexpr (!MLA) { const int dmin_ = q0 + wid * 32 - 64 * (t_) - 63; \
        if (dmin_ < 559) { const LAS float* tb_ = (const LAS float*)(lds + C::LDS_BIAS) + (dmin_ + r32 + 126 - 4 * hi); \
            _Pragma("unroll") for (int r = 0; r < 16; ++r) { const int kk_ = (r & 3) + 8 * (r >> 2); c0[r] += tb_[-kk_]; c1[r] += tb_[-kk_ - 32]; } } } } while (0)
#define EXPW(w_) do { if ((w_) < 8) { c0[(2 * (w_)) & 15] = __builtin_amdgcn_exp2f(c0[(2 * (w_)) & 15]); c0[(2 * (w_) + 1) & 15] = __builtin_amdgcn_exp2f(c0[(2 * (w_) + 1) & 15]); } \
        else { c1[(2 * (w_)) & 15] = __builtin_amdgcn_exp2f(c1[(2 * (w_)) & 15]); c1[(2 * (w_) + 1) & 15] = __builtin_amdgcn_exp2f(c1[(2 * (w_) + 1) & 15]); } } while (0)
#define PACKW(PWN_, w_) do { const float a_ = CE(2 * (w_)), b_ = CE(2 * (w_) + 1); sacc_ += a_ + b_; PWN_[(w_) / 4][(w_) % 4] = cvtpk(a_, b_); } while (0)
#define STEP(t_, PWC_, PWN_) do { \
        const lds_cptr kp_ = kp0 + ks0, vp_ = vp0 + vsm; \
        __builtin_amdgcn_sched_barrier(0); \
        _Pragma("unroll") for (int g = 0; g < NQK; ++g) { const bf16x8 f_ = W_FRAG(g); \
            if ((g & 1) == 0) c0 = (g / 2 == 0) ? __builtin_amdgcn_mfma_f32_32x32x16_bf16(f_, qr[0], (f32x16){}, 0, 0, 0) : __builtin_amdgcn_mfma_f32_32x32x16_bf16(f_, qr[g / 2], c0, 0, 0, 0); \
            else c1 = (g / 2 == 0) ? __builtin_amdgcn_mfma_f32_32x32x16_bf16(f_, qr[0], (f32x16){}, 0, 0, 0) : __builtin_amdgcn_mfma_f32_32x32x16_bf16(f_, qr[g / 2], c1, 0, 0, 0); \
            if (g + WD < NOPS) W_LOAD(g + WD); \
            if (g == 1) { if ((t_) + 3 < NT) DMA_K((t_) + 3, ks3); } \
            if (g == 3) { if ((t_) + 1 < NT) DMA_V((t_) + 1, vs1); } \
            __builtin_amdgcn_sched_barrier(0); } \
        BIAS(t_); \
        __builtin_amdgcn_sched_barrier(0); \
        float sacc_ = 0.f; \
        _Pragma("unroll") for (int h = 0; h < NPV; ++h) { const bf16x8 f_ = W_FRAG(NQK + h); \
            o[h / 4] = __builtin_amdgcn_mfma_f32_32x32x16_bf16(__builtin_bit_cast(bf16x8, PWC_[h % 4]), f_, o[h / 4], 0, 0, 0); \
            if (NQK + h + WD < NOPS) W_LOAD(NQK + h + WD); \
            EXPW(h); if (h >= 1) PACKW(PWN_, h - 1); \
            asm volatile("" : "+v"(sacc_)); \
            __builtin_amdgcn_sched_barrier(0); } \
        PACKW(PWN_, 15); l_reg += sacc_; \
        PREFILL(t_); \
    } while (0)
#define DRAIN() do { f32x16 d0_ = f32x16{}, d1_ = f32x16{}; const f32x16 z_ = f32x16{}; mfma_slot<NKS, ND, true, false>(o, d0_, d1_, pwc, qr, z_, kp0 + ks0, vp0 + vsm); } while (0)
#define AT_CLOSE(t_) do { const int cnt_ = (((t_) + 3 < NT) ? C::NKD : 0) + (((t_) + 1 < NT) ? C::NVD : 0); \
        if (cnt_ == 3) { AT_WAITBAR_NL(3); } else if (cnt_ == 2) { AT_WAITBAR_NL(2); } else if (cnt_ == 1) { AT_WAITBAR_NL(1); } else { AT_WAITBAR_NL(0); } } while (0)
#define ROTATE() do { const int k_ = ks0; ks0 = ks1; ks1 = ks2; ks2 = ks3; ks3 = k_; const int v_ = vsm; vsm = vs0; vs0 = vs1; vs1 = v_; } while (0)
#define PW_ADVANCE() do { _Pragma("unroll") for (int k = 0; k < 4; ++k) pwc[k] = pwn[k]; } while (0)
    { ISSUE_DMA(0);
      const f32x16 z_ = f32x16{};
      mfma_slot<NKS, ND, false, true>(o, c0, c1, pwc, qr, z_, kp0 + ks0, vp0 + vsm);
      BIAS(0);
      float sacc_ = 0.f;
#pragma unroll
      for (int w = 0; w < 16; ++w) { EXPW(w); PACKW(pwc, w); }
      l_reg += sacc_;
      PREFILL(0);
      AT_CLOSE(0); ROTATE(); }
    int t = 1; const int tlast = tmax < NT - 1 ? tmax : NT - 1;
#pragma unroll 1
    for (; t + 1 <= tlast; t += 2) {
        STEP(t, pwc, pwn); AT_CLOSE(t); ROTATE();
        STEP(t + 1, pwn, pwc); AT_CLOSE(t + 1); ROTATE();
    }
    if (t <= tlast) { STEP(t, pwc, pwn); PW_ADVANCE(); AT_CLOSE(t); ROTATE(); ++t; }
    if (t < NT) { ISSUE_DMA(t); DRAIN(); AT_CLOSE(t); ROTATE(); ++t; }
#pragma unroll 1
    for (; t < NT; ++t) { ISSUE_DMA(t); AT_CLOSE(t); ROTATE(); }
    if (tmax == NT - 1) { DRAIN(); }
#undef CE
#undef W_LOAD
#undef W_FRAG
#undef ISSUE_DMA
#undef PREFILL
#undef BIAS
#undef EXPW
#undef PACKW
#undef STEP
#undef DRAIN
#undef ROTATE
#undef PW_ADVANCE
    unsigned nx_ = 0u; if (P.qhead != nullptr && wid == 0 && lane == 0) nx_ = __hip_atomic_fetch_add(P.qhead, 1u, __ATOMIC_RELAXED, __HIP_MEMORY_SCOPE_AGENT) + P.qbase;
    { auto rr = __builtin_amdgcn_permlane32_swap(__float_as_uint(l_reg), __float_as_uint(l_reg), false, false); l_reg = __uint_as_float(rr[0]) + __uint_as_float(rr[1]); }
    if (hi == 0) wsf[32 + r32] = l_reg;
    asm volatile("s_waitcnt lgkmcnt(0)" ::: "memory");
    { int le = lane; asm volatile("" : "+v"(le));
      const int r32e = le & 31, hie = le >> 5;
      LAS bf16_t* stg = (LAS bf16_t*)(lds + C::LDS_OST + wid * C::OSTW);
      constexpr int RW = ND * 32;
#pragma unroll
      for (int r = 0; r < 16; ++r) { const int orow = (r & 3) + 8 * (r >> 2); const float rl = __builtin_amdgcn_rcpf(wsf[32 + 4 * hie + orow]);
#pragma unroll
          for (int d0 = 0; d0 < ND; ++d0) { const unsigned w = cvtpk(o[d0][r] * rl, 0.f); stg[(4 * hie + r32e) + orow * RW + d0 * 32 + (RW - 1) * 4 * hie] = (bf16_t)(w & 0xffffu); } }
      asm volatile("s_waitcnt lgkmcnt(0)" ::: "memory");
      constexpr int CPR = ND * 4, RPI = 64 / CPR;
      const int rowl = le / CPR, ch = le % CPR;
      const LAS bf16_t* sp = stg + rowl * RW + ch * 8;
      bf16_t* Ow = P.O + (size_t)(P.rowbase + q0 + wid * 32 + rowl) * P.ldo + ch * 8;
      if (MLA || P.O1 == nullptr) {
#pragma unroll
          for (int i = 0; i < ND * 2; ++i) { const u32x4 v = *(const LAS u32x4*)(sp + i * RPI * RW); *(u32x4*)(Ow + (size_t)(i * RPI) * P.ldo) = v; }
      } else {
          const float lam = *P.lamp; const f32x4 g0 = *(const f32x4*)(P.gout + ch * 8) * 0.8f, g1 = *(const f32x4*)(P.gout + ch * 8 + 4) * 0.8f;
          const bf16_t* O1p = P.O1 + (size_t)(P.rowbase + q0 + wid * 32 + rowl) * 1024 + ch * 8; bf16_t* Yp = P.Yc + (size_t)(P.rowbase + q0 + wid * 32 + rowl) * 1024 + ch * 8;
#pragma unroll
          for (int i = 0; i < ND * 2; ++i) { const u32x4 v2 = *(const LAS u32x4*)(sp + i * RPI * RW); const u32x4 v1 = *(const u32x4*)(O1p + (size_t)(i * RPI) * 1024);
              f32x4 a = (f32x4){bflo(v1.x) - lam * bflo(v2.x), bfhi(v1.x) - lam * bfhi(v2.x), bflo(v1.y) - lam * bflo(v2.y), bfhi(v1.y) - lam * bfhi(v2.y)};
              f32x4 b = (f32x4){bflo(v1.z) - lam * bflo(v2.z), bfhi(v1.z) - lam * bfhi(v2.z), bflo(v1.w) - lam * bflo(v2.w), bfhi(v1.w) - lam * bfhi(v2.w)};
              float ss = sq4(a) + sq4(b); ss += __shfl_xor(ss, 1); ss += __shfl_xor(ss, 2); ss += __shfl_xor(ss, 4); ss += __shfl_xor(ss, 8);
              const float r = rsqrtf(ss * (1.0f / 128.0f) + EPS);
              *(u32x4*)(Yp + (size_t)(i * RPI) * 1024) = pack8(a * g0 * r, b * g1 * r); }
      } }
    if (P.qhead != nullptr && wid == 0 && lane == 0) *P.qw = nx_;
    AT_BAR();
#undef DMA_K
#undef DMA_V
#undef AT_CLOSE
}
}

constexpr int NWAVES = 8;
#ifndef IW_MLA
#define IW_MLA 1
#endif
#ifndef IW_DIFF
#define IW_DIFF 1
#endif
constexpr int N_PHASES = 10;
#ifndef MK_N_LAUNCHES
#define MK_N_LAUNCHES 1
#endif
constexpr size_t MiB = 1u << 20;
constexpr size_t WS_CTL = 0, CTL_ZERO_BYTES = 64 * 1024;
constexpr size_t WS_WIN = 1 * MiB;
constexpr size_t WS_WUP = 5 * MiB;
constexpr size_t WS_WOUT = 7 * MiB;
constexpr size_t WS_WG = 9 * MiB;
constexpr size_t WS_WU = WS_WG + (size_t)2816 * 1024 * 2;
constexpr size_t WS_WD = 21 * MiB;
constexpr size_t WS_WPG = 27 * MiB;
constexpr size_t WS_WPP = 29 * MiB;
constexpr size_t WS_ROPE = 30 * MiB;
constexpr size_t WS_BTAB = 31 * MiB;
constexpr size_t WS_SSQ = 32 * MiB;
constexpr size_t WS_SSKV = 33 * MiB;
constexpr size_t WS_KRSS = 34 * MiB;
constexpr size_t WS_KRR = 35 * MiB;
constexpr size_t WS_SS1 = 40 * MiB;
constexpr size_t WS_SS2 = 43 * MiB;
constexpr size_t WS_PB = 48 * MiB;
constexpr size_t WS_XN = 64 * MiB;
constexpr size_t WS_Z = 128 * MiB;
constexpr size_t WS_DKI = 192 * MiB;
constexpr size_t WS_DVI = 224 * MiB;
constexpr size_t WS_QR = 256 * MiB;
constexpr size_t WS_KM = 304 * MiB;
constexpr size_t WS_VM = 352 * MiB;
constexpr size_t WS_Y = 384 * MiB;
constexpr size_t WS_OD = 448 * MiB;
constexpr size_t WS_X1B = WS_XN;
constexpr size_t WS_G = 128 * MiB;
constexpr size_t WS_ACT = 304 * MiB;
constexpr size_t WS_X2B = 128 * MiB;
constexpr size_t WS_PR = 64 * MiB;
constexpr size_t WS_END = 512 * MiB;
constexpr int CW_P2DONE = 8256;
constexpr int CW_GDONE = 8320;
constexpr int CW_P3DONE = 8384;
constexpr int CW_Q = 8192;
constexpr int CW_BAR = 1024;
constexpr int RING_BYTES = 131072, LDS_BYTES = 155648, MISC_OFF = LDS_BYTES - 256;
static_assert(attn::Cfg<4, 4, 4>::LDS_END <= MISC_OFF && attn::Cfg<6, 2, 4>::LDS_END <= MISC_OFF && MISC_OFF + 256 <= 160 * 1024, "attention LDS map");

typedef GAS unsigned gu32;
#define VM_WAIT() asm volatile("s_waitcnt vmcnt(0)" ::: "memory")
#define LDS_WAIT() asm volatile("s_waitcnt lgkmcnt(0)" ::: "memory")

#define XB_TMO      128
#define XB_XCNT(j)  (256  + 64 * (j))
#define XB_XSUB(j)  (1280 + 64 * (j))
#define XB_XGEN(j)  (2304 + 64 * (j))
#define XB_TOP      3328
#define XB_TOPGEN   3392
#define XCD_BAR_WORDS 3456
#define XB_SPIN_CAP (1u << 18)
__device__ __forceinline__ unsigned xb_ld(unsigned* p)              { return __hip_atomic_load(p, __ATOMIC_RELAXED, __HIP_MEMORY_SCOPE_AGENT); }
__device__ __forceinline__ unsigned xb_add(unsigned* p, unsigned v) { return __hip_atomic_fetch_add(p, v, __ATOMIC_RELAXED, __HIP_MEMORY_SCOPE_AGENT); }
__device__ __forceinline__ unsigned xb_xcc_id() { return (unsigned)__builtin_amdgcn_s_getreg((3 << 11) | 20) & 0xFu; }
#define XB_SPIN(cond, bar) do { unsigned _sp = 0; while (cond) { __builtin_amdgcn_s_sleep(1); \
    if ((++_sp & 255u) == 0u) { if (xb_ld(&(bar)[XB_TMO])) break; if (_sp > XB_SPIN_CAP) { atomicAdd(&(bar)[XB_TMO], 1u); break; } } } } while (0)
struct XcdBarrier { unsigned* bar; unsigned x; volatile LAS unsigned* st; };
__device__ __forceinline__ XcdBarrier xcd_barrier_post(unsigned* bar, volatile LAS unsigned* st) {
    XcdBarrier b; b.bar = bar; b.x = xb_xcc_id(); b.st = st;
    if (threadIdx.x == 0) (void)xb_add(&bar[XB_XCNT(b.x)], 1u);
    return b;
}
__device__ __forceinline__ void xcd_barrier_complete(unsigned* bar, unsigned x, unsigned& nloc, unsigned& nx) {
    const unsigned G = gridDim.x * gridDim.y * gridDim.z;
    unsigned sum, cnt, mine, sp = 0u;
    for (;;) {
        sum = 0u; cnt = 0u; mine = 0u;
#pragma unroll
        for (unsigned j = 0; j < 16; ++j) { const unsigned c = xb_ld(&bar[XB_XCNT(j)]); sum += c; cnt += (c > 0u) ? 1u : 0u; mine = (j == x) ? c : mine; }
        if (sum == G) break;
        __builtin_amdgcn_s_sleep(1);
        if ((++sp & 255u) == 0u) { if (xb_ld(&bar[XB_TMO])) break; if (sp > XB_SPIN_CAP) { atomicAdd(&bar[XB_TMO], 1u); break; } }
    }
    nloc = mine > 0u ? mine : 1u; nx = cnt > 0u ? cnt : 1u;
}
__device__ __forceinline__ void xcd_barrier(const XcdBarrier& b) {
    asm volatile("s_waitcnt vmcnt(0)" ::: "memory");
    __syncthreads();
    if (threadIdx.x == 0) {
        unsigned* bar = b.bar;
        __builtin_amdgcn_s_waitcnt(0);
        unsigned nloc = b.st[0], nx = b.st[1];
        if (nloc == 0u) { xcd_barrier_complete(bar, b.x, nloc, nx); b.st[0] = nloc; b.st[1] = nx; }
        const unsigned old = xb_add(&bar[XB_XSUB(b.x)], 1u);
        const unsigned gen = old / nloc;
        if (old + 1u == (gen + 1u) * nloc) {
            __builtin_amdgcn_fence(__ATOMIC_RELEASE, "agent");
            asm volatile("s_waitcnt vmcnt(0)" ::: "memory");
            const unsigned og = xb_add(&bar[XB_TOP], 1u);
            const unsigned tg = og / nx;
            if (og + 1u == (tg + 1u) * nx) xb_add(&bar[XB_TOPGEN], 1u);
            else XB_SPIN(xb_ld(&bar[XB_TOPGEN]) == tg, bar);
            __builtin_amdgcn_fence(__ATOMIC_ACQUIRE, "agent");
            xb_add(&bar[XB_XGEN(b.x)], 1u);
            asm volatile("s_waitcnt vmcnt(0)" ::: "memory");
        } else {
            XB_SPIN(xb_ld(&bar[XB_XGEN(b.x)]) == gen, bar);
            __builtin_amdgcn_fence(__ATOMIC_ACQUIRE, "agent");
            asm volatile("s_waitcnt vmcnt(0)" ::: "memory");
        }
    }
    __syncthreads();
}

struct Args { const float* in[28]; float* out; unsigned char* ws; int ph_lo, ph_hi; };

__device__ __forceinline__ float wave_sum(float v) {
#pragma unroll
    for (int o = 1; o < 64; o <<= 1) v += __shfl_xor(v, o);
    return v;
}
__device__ __forceinline__ int t5_bucket(int rel) {
    const int nb = 16, max_exact = 8;
    const int sign_off = rel > 0 ? nb : 0;
    const int n = rel < 0 ? -rel : rel;
    const float nf = (float)(n > 1 ? n : 1);
    int large = max_exact + (int)(logf(nf / 8.0f) / 4.852030263919617f * 8.0f);
    large = large < nb - 1 ? large : nb - 1;
    return sign_off + (n < max_exact ? n : large);
}

__device__ __forceinline__ void wt_item(const float* W, int ldw, int srccol0, int srck0, const float* gain, bf16_t* WT, int ldk, int dstrow0, int dstk0, LAS float* scr, int lane) {
    const int c = lane & 7;
    if (W == nullptr) {
#pragma unroll
        for (int j = 0; j < 4; ++j) { const int n = (lane >> 3) + 8 * j; *(GAS u32x4*)(WT + (size_t)(dstrow0 + n) * ldk + dstk0 + 8 * c) = (u32x4){0u, 0u, 0u, 0u}; }
        return;
    }
    float wv[32];
#pragma unroll
    for (int i = 0; i < 32; ++i) { const int kk = 2 * i + (lane >> 5); wv[i] = __builtin_nontemporal_load(W + (size_t)(srck0 + kk) * ldw + srccol0 + (lane & 31)); }
    if (gain) {
#pragma unroll
        for (int i = 0; i < 32; ++i) wv[i] *= gain[srck0 + 2 * i + (lane >> 5)];
    }
#pragma unroll
    for (int i = 0; i < 32; ++i) scr[(2 * i + (lane >> 5)) * 33 + (lane & 31)] = wv[i];
    LDS_WAIT(); asm volatile("" ::: "memory");
#pragma unroll
    for (int j = 0; j < 4; ++j) { const int n = (lane >> 3) + 8 * j; const LAS float* s = scr + (8 * c) * 33 + n;
        u32x4 o; o.x = cvtpk(s[0 * 33], s[1 * 33]); o.y = cvtpk(s[2 * 33], s[3 * 33]); o.z = cvtpk(s[4 * 33], s[5 * 33]); o.w = cvtpk(s[6 * 33], s[7 * 33]);
        *(GAS u32x4*)(WT + (size_t)(dstrow0 + n) * ldk + dstk0 + 8 * c) = o; }
    LDS_WAIT(); asm volatile("" ::: "memory");
}

__device__ __forceinline__ int win_src_col(int b32) {
    const int pn = b32 >> 3, q = b32 & 7, bj = q >> 2, wc = q & 3;
    if (pn == 0) return OFF_Q_LAT + 32 * q;
    if (pn == 1) return bj == 0 ? OFF_KV_LAT + 32 * wc : (wc == 0 ? OFF_K_ROPE : -1);
    if (pn < 4) return OFF_DIFF_Q + 64 * (4 * (pn - 2) + wc) + 32 * bj;
    if (pn < 6) return OFF_DIFF_K + 64 * (4 * (pn - 4) + wc) + 32 * bj;
    return OFF_DIFF_V + 256 * (pn - 6) + 32 * q;
}


typedef const __attribute__((address_space(4))) Args* KArgs;
#define PHASE_PTRS() \
    KArgs ap = (KArgs)__builtin_amdgcn_kernarg_segment_ptr(); asm volatile("" : "+s"(ap)); \
    unsigned char* const ws = ap->ws; float* const out = ap->out; (void)out; \
    const float* const x = ap->in[0]; const float* const p_in = ap->in[1]; const float* const attn_norm_g = ap->in[2]; const float* const w_in = ap->in[3]; \
    const float* const q_lat_norm_g = ap->in[4]; const float* const w_uq = ap->in[5]; const float* const kv_lat_norm_g = ap->in[6]; const float* const w_ukv = ap->in[7]; \
    const float* const mla_q_norm_g = ap->in[8]; const float* const mla_k_norm_g = ap->in[9]; const float* const diff_q_norm_g = ap->in[10]; const float* const diff_k_norm_g = ap->in[11]; \
    const float* const lq1 = ap->in[12]; const float* const lk1 = ap->in[13]; const float* const lq2 = ap->in[14]; const float* const lk2 = ap->in[15]; \
    const float* const diff_out_norm_g = ap->in[16]; const float* const rel_bias = ap->in[17]; const float* const w_out = ap->in[18]; const float* const ffn_norm_g = ap->in[19]; \
    const float* const w_gate = ap->in[20]; const float* const w_up = ap->in[21]; const float* const conv_w = ap->in[22]; const float* const conv_b = ap->in[23]; const float* const w_down = ap->in[24]; \
    const float* const ple_norm_g = ap->in[25]; const float* const w_ple_gate = ap->in[26]; const float* const w_ple_proj = ap->in[27]; \
    bf16_t* const WIN = (bf16_t*)(ws + WS_WIN); bf16_t* const WUP = (bf16_t*)(ws + WS_WUP); bf16_t* const WUKV = (bf16_t*)(ws + WS_WUP + 512 * 1024); bf16_t* const WOUT = (bf16_t*)(ws + WS_WOUT); bf16_t* const WG = (bf16_t*)(ws + WS_WG); \
    bf16_t* const WU = (bf16_t*)(ws + WS_WU); bf16_t* const WD = (bf16_t*)(ws + WS_WD); bf16_t* const WPG = (bf16_t*)(ws + WS_WPG); bf16_t* const WPP = (bf16_t*)(ws + WS_WPP); \
    float* const ROPE = (float*)(ws + WS_ROPE); float* const BTAB = (float*)(ws + WS_BTAB); \
    float* const SSQ = (float*)(ws + WS_SSQ); float* const SSKV = (float*)(ws + WS_SSKV); float* const KRSS = (float*)(ws + WS_KRSS); float* const KRR = (float*)(ws + WS_KRR); \
    float* const SS1 = (float*)(ws + WS_SS1); float* const SS2 = (float*)(ws + WS_SS2); \
    bf16_t* const PB = (bf16_t*)(ws + WS_PB); bf16_t* const XN = (bf16_t*)(ws + WS_XN); bf16_t* const Z = (bf16_t*)(ws + WS_Z); bf16_t* const QR = (bf16_t*)(ws + WS_QR); \
    bf16_t* const KM = (bf16_t*)(ws + WS_KM); bf16_t* const VM = (bf16_t*)(ws + WS_VM); bf16_t* const DKI = (bf16_t*)(ws + WS_DKI); bf16_t* const DVI = (bf16_t*)(ws + WS_DVI); bf16_t* const Y = (bf16_t*)(ws + WS_Y); bf16_t* const OD = (bf16_t*)(ws + WS_OD); \
    bf16_t* const X1B = (bf16_t*)out; bf16_t* const GT = (bf16_t*)(ws + WS_G); bf16_t* const ACT = (bf16_t*)(ws + WS_ACT); bf16_t* const X2B = (bf16_t*)(ws + WS_X2B); bf16_t* const PRB = (bf16_t*)(ws + WS_PR); \
    (void)x; (void)p_in; (void)attn_norm_g; (void)w_in; (void)q_lat_norm_g; (void)w_uq; (void)kv_lat_norm_g; (void)w_ukv; (void)mla_q_norm_g; (void)mla_k_norm_g; (void)diff_q_norm_g; (void)diff_k_norm_g; \
    (void)lq1; (void)lk1; (void)lq2; (void)lk2; (void)diff_out_norm_g; (void)rel_bias; (void)w_out; (void)ffn_norm_g; (void)w_gate; (void)w_up; (void)conv_w; (void)conv_b; (void)w_down; (void)ple_norm_g; (void)w_ple_gate; (void)w_ple_proj; \
    (void)WIN; (void)WUP; (void)WUKV; (void)WOUT; (void)WG; (void)WU; (void)WD; (void)WPG; (void)WPP; (void)ROPE; (void)BTAB; (void)SSQ; (void)SSKV; (void)KRSS; (void)KRR; (void)SS1; (void)SS2; (void)PB; (void)XN; (void)Z; (void)QR; (void)KM; (void)VM; (void)DKI; (void)DVI; (void)Y; (void)OD; (void)X1B; (void)GT; (void)ACT; (void)X2B; (void)PRB

__device__ __forceinline__ void ffn_wait(unsigned* cnt, int G) {
    if (threadIdx.x == 0) { unsigned sp_ = 0u; while (__hip_atomic_load(cnt, __ATOMIC_RELAXED, __HIP_MEMORY_SCOPE_AGENT) < (unsigned)G && ++sp_ < (1u << 22)) __builtin_amdgcn_s_sleep(2);
                            __builtin_amdgcn_fence(__ATOMIC_ACQUIRE, "agent"); }
    __syncthreads();
}
struct EpiUpActW {
    EpiUpAct eu; unsigned* cnt; int G, u0_pm, u0_pn, u1_pm, u1_pn;
    __device__ __forceinline__ void operator()(const AccT& acc, const pg8::Unit& u, int wr, int wc, int fr, int fq) const {
        if (u.pm == u0_pm && u.pn == u0_pn) ffn_wait(cnt, G);
        else if (u.pm == u1_pm && u.pn == u1_pn) ffn_wait(cnt + 16, G);
        eu(acc, u, wr, wc, fr, fq);
    }
};
struct EpiGateW {
    EpiGate eg; unsigned* cnt; int p5_pm, p5_pn;
    __device__ __forceinline__ void operator()(const AccT& acc, const pg8::Unit& u, int wr, int wc, int fr, int fq) const {
        eg(acc, u, wr, wc, fr, fq);
        if (u.pm == p5_pm && u.pn == p5_pn) {
            asm volatile("s_waitcnt vmcnt(0)" ::: "memory"); __syncthreads();
            if (threadIdx.x == 0) { __builtin_amdgcn_fence(__ATOMIC_RELEASE, "agent"); (void)__hip_atomic_fetch_add(cnt, 1u, __ATOMIC_RELAXED, __HIP_MEMORY_SCOPE_AGENT); } }
    }
};
__global__ void __launch_bounds__(NWAVES * 64, 2) mk_fwd(Args args) {
    extern __shared__ __attribute__((aligned(16))) unsigned char lds_raw[];
    LAS unsigned char* lds = (LAS unsigned char*)lds_raw;
    volatile LAS unsigned* MISC = (volatile LAS unsigned*)(lds + MISC_OFF);
    const int tid = threadIdx.x, lane = tid & 63, wave = __builtin_amdgcn_readfirstlane(tid >> 6);
    const int G = gridDim.x, bx = blockIdx.x;
    const int vcu = (G % 8 == 0) ? (bx % 8) * (G / 8) + bx / 8 : bx;
    gu32* ctl = (gu32*)(args.ws + WS_CTL);
    if (tid < 64) MISC[tid] = 0u;
    __syncthreads();
    XcdBarrier bar = xcd_barrier_post((unsigned*)ctl + CW_BAR, MISC + 8);
    const int lo = args.ph_lo, hi_ph = args.ph_hi;
#ifndef PH_MASK
#define PH_MASK 0x3ff
#endif
#define IN(k) (((PH_MASK >> (k)) & 1) && lo <= (k) && (k) < hi_ph)
#define BOTH(k) (IN(k) && IN((k) + 1))
#ifndef REP_MASK
#define REP_MASK 0
#endif
#define NREP(k) (1 + ((REP_MASK >> (k)) & 1))
#define GRID_BAR() xcd_barrier(bar)
    const int gw = vcu * NWAVES + wave, NGW = G * NWAVES;

    if (IN(0)) {
        PHASE_PTRS();
        LAS float* scr = (LAS float*)(lds + wave * 16384);
        constexpr int I_IN = 64 * 16, I_UQ = 24 * 4, I_UKV = 32 * 2, I_OUT = 32 * 16, I_G = 88 * 16, I_U = 88 * 16, I_D = 32 * 44, I_PG = 32 * 16, I_PP = 32 * 4;
        constexpr int NITEMS = I_IN + I_UQ + I_UKV + I_PP;
        (void)I_D; (void)I_PG; (void)I_OUT; (void)I_G; (void)I_U; (void)I_PP;
        for (int it = gw; it < NITEMS; it += NGW) {
            int r = it;
            if (r < I_IN) { const int nb = r / 16, kb = r % 16; const int sc = win_src_col(nb);
                wt_item(sc < 0 ? nullptr : w_in, IN_COLS, sc, 64 * kb, attn_norm_g, WIN, 1024, 32 * nb, 64 * kb, scr, lane); continue; } r -= I_IN;
            if (r < I_UQ) { wt_item(w_uq, 768, 32 * (r / 4), 64 * (r % 4), q_lat_norm_g, WUP, 256, 32 * (r / 4), 64 * (r % 4), scr, lane); continue; } r -= I_UQ;
            if (r < I_UKV) { const int nb = r / 2, kb = r % 2; const int pn = nb >> 3, q = nb & 7, bj = q >> 2, wc = q & 3;
                int sc; if (pn < 2) sc = 128 * (4 * pn + wc) + 32 * bj; else { const int p0 = 256 * (pn - 2) + 32 * q; sc = 128 * (p0 / 64) + 64 + (p0 % 64); }
                wt_item(w_ukv, 1024, sc, 64 * kb, kv_lat_norm_g, WUKV, 128, 32 * nb, 64 * kb, scr, lane); continue; } r -= I_UKV;
            wt_item(w_ple_proj, 1024, 32 * (r / 4), 64 * (r % 4), nullptr, WPP, 256, 32 * (r / 4), 64 * (r % 4), scr, lane);
        }
        for (int m0 = gw * 4; m0 < T_TOK; m0 += NGW * 4) {
            f32x4 v[4][4]; float s[4];
#pragma unroll
            for (int q = 0; q < 4; ++q) { const GAS f32x4* xr = (const GAS f32x4*)(x + (size_t)(m0 + q) * D_MODEL) + lane;
#pragma unroll
                for (int j = 0; j < 4; ++j) v[q][j] = __builtin_nontemporal_load(xr + 64 * j); }
#pragma unroll
            for (int q = 0; q < 4; ++q) { s[q] = 0.f;
#pragma unroll
                for (int j = 0; j < 4; ++j) s[q] += sq4(v[q][j]); }
#pragma unroll
            for (int q = 0; q < 4; ++q) { const float r = rsqrtf(wave_sum(s[q]) * (1.0f / D_MODEL) + EPS);
                GAS u32x2* o8 = (GAS u32x2*)(XN + (size_t)(m0 + q) * D_MODEL) + lane;
#pragma unroll
                for (int j = 0; j < 4; ++j) o8[64 * j] = (u32x2){cvtpk(v[q][j][0] * r, v[q][j][1] * r), cvtpk(v[q][j][2] * r, v[q][j][3] * r)}; }
        }
        { const size_t n8 = ((T_TOK / 256) * (D_FF / 256) % G == 0) ? (size_t)T_TOK * PLE_DIM / 8 : 0;
          const size_t gt = (size_t)vcu * (NWAVES * 64) + tid, NGT = (size_t)G * NWAVES * 64;
          for (size_t i = gt; i < n8; i += 4 * NGT) { f32x4 a[4], b[4];
#pragma unroll
              for (int q = 0; q < 4; ++q) { const size_t ii = i + q * NGT; if (ii < n8) { a[q] = *(const GAS f32x4*)(p_in + ii * 8); b[q] = *(const GAS f32x4*)(p_in + ii * 8 + 4); } }
#pragma unroll
              for (int q = 0; q < 4; ++q) { const size_t ii = i + q * NGT; if (ii < n8) *(GAS u32x4*)(PB + ii * 8) = pack8(a[q], b[q]); } }
          for (size_t i = gt; i < (size_t)SEQ * 16; i += NGT) { const int pos = (int)(i >> 4), k = (int)(i & 15); const float inv = powf(10000.0f, -(float)k / 16.0f); const float ang = (float)pos * inv;
              ROPE[(size_t)pos * 32 + k] = cosf(ang); ROPE[(size_t)pos * 32 + 16 + k] = sinf(ang); }
          for (size_t i = gt; i < 4096; i += NGT) { const int h = (int)(i >> 10), k = (int)(i & 1023); BTAB[i] = (rel_bias[t5_bucket(63 - k) * 4 + h] - rel_bias[15 * 4 + h]) * LOG2E; }
          if (gw == 0) {
              const float s1 = wave_sum(lq1[lane] * lk1[lane]), s2 = wave_sum(lq2[lane] * lk2[lane]);
              float mq = fmaxf(fabsf(mla_q_norm_g[lane]), lane < 32 ? fabsf(mla_q_norm_g[64 + lane]) : 0.f), mk = fmaxf(fabsf(mla_k_norm_g[lane]), lane < 32 ? fabsf(mla_k_norm_g[64 + lane]) : 0.f);
              float dq = fabsf(diff_q_norm_g[lane]), dk = fabsf(diff_k_norm_g[lane]), mb = fmaxf(fabsf(rel_bias[lane]), fabsf(rel_bias[64 + lane]));
#pragma unroll
              for (int o = 1; o < 64; o <<= 1) { mq = fmaxf(mq, __shfl_xor(mq, o)); mk = fmaxf(mk, __shfl_xor(mk, o)); dq = fmaxf(dq, __shfl_xor(dq, o)); dk = fmaxf(dk, __shfl_xor(dk, o)); mb = fmaxf(mb, __shfl_xor(mb, o)); }
              if (lane == 0) { BTAB[4096] = expf(s1) - expf(s2) + 0.2f;
                  BTAB[4097] = 96.0f * mq * mk * 0.10206207261596577f * LOG2E;
                  BTAB[4098] = 64.0f * dq * dk * 0.125f * LOG2E + 2.0f * mb * LOG2E; } }
        }
        if (BOTH(0)) GRID_BAR();
    }
    if (IN(1)) for (int rep_ = 0; rep_ < NREP(1); ++rep_) {
        PHASE_PTRS();
        pg8::Gemm g{XN, WIN, T_TOK, 2048, 1024, 1024}; pg8::StaticOrder S; S.init(T_TOK, 2048, G, bx);
        EpiIn E{Z, DKI, DVI, SSQ, SSKV, KRR, KRSS, ROPE, diff_q_norm_g, diff_k_norm_g, mla_k_norm_g};
        pg8::gemm_phase(lds, g, S, E);
        if (BOTH(1)) GRID_BAR();
    }
    if (IN(2)) for (int rep_ = 0; rep_ < NREP(2); ++rep_) {
        PHASE_PTRS();
        int kq = 256, kkv = 128; asm volatile("" : "+s"(kq), "+s"(kkv));
        const int hq = (G * 5) / 16;
        if (bx < hq) { pg8::Gemm g{Z, WUP, T_TOK, 768, kq, ZLD}; IdleOrder S{0, bx, hq, (T_TOK / 256) * 3, 3};
          EpiUp<false> E{QR, KM, VM, SSQ, SSKV, KRR, KRSS, mla_k_norm_g}; pg8::gemm_phase(lds, g, S, E); }
        else { pg8::Gemm g{Z + 256, WUKV, T_TOK, 1024, kkv, ZLD}; IdleOrder S{0, bx - hq, G - hq, (T_TOK / 256) * 4, 4};
          EpiUp<true> E{QR, KM, VM, SSQ, SSKV, KRR, KRSS, mla_k_norm_g}; pg8::gemm_phase(lds, g, S, E); }
        asm volatile("s_waitcnt vmcnt(0)" ::: "memory"); __syncthreads();
        if (tid == 0) { __builtin_amdgcn_fence(__ATOMIC_RELEASE, "agent"); (void)__hip_atomic_fetch_add((unsigned*)ctl + CW_P2DONE, 1u, __ATOMIC_RELAXED, __HIP_MEMORY_SCOPE_AGENT); }
    }
    if (IN(3)) {
        PHASE_PTRS();
        const bool att_fixed_mla = BTAB[4097] >= 0.f && BTAB[4097] < 64.0f, att_fixed_diff = BTAB[4098] >= 0.f && BTAB[4098] < 64.0f;
        { volatile LAS unsigned* QW = MISC + 16; unsigned* qhead = (unsigned*)ctl + CW_Q;
          constexpr int N_DIFF = 512, N_ATT = 512 + 1024, CV_TILES = 32 * 16 + 88 * 16 + 88 * 16 + 32 * 44 + 32 * 16, CV_PER = 32, N_ITEMS = N_ATT + CV_TILES / CV_PER;
          static_assert(CV_TILES % CV_PER == 0, "whole chunks");
          int item = bx; bool p2ok = false;
          while (item < N_ITEMS) {
            if (item < N_DIFF) { const int qb = 31 - (item >> 4), b = (item & 15) >> 2, h = item & 3;
#pragma unroll 1
              for (int m = 0; m < 2; ++m) { const int hm = 2 * h + m;
                attn::UnitP P{Z + Z_DQ + 64 * hm, ZLD, DKI + kimg(8, b * 8 + hm, 0, 0, 0), 0, DVI + vimg(4, b * 4 + h, 0, 0, 0, 0, 0), 0, OD + 128 * hm, 1024, qb, (long)b * SEQ, BTAB + 1024 * h, BTAB + 4098,
                              m ? OD + 128 * (2 * h) : nullptr, Y + 512 + 128 * h, diff_out_norm_g, BTAB + 4096, m ? qhead : nullptr, (unsigned)G, QW};
                if (IW_DIFF && att_fixed_diff) attn::attn_unit_iw2<4, 4, false>(P, lds, nullptr, nullptr); else attn::attn_unit<4, 4, false>(P, lds, nullptr, nullptr); }
            } else if (item >= N_ATT) {
              PHASE_PTRS();
              LAS float* scr = (LAS float*)(lds + wave * 16384);
#pragma unroll 1
              for (int jt = 0; jt < CV_PER / NWAVES; ++jt) { int r = (item - N_ATT) * CV_PER + jt * NWAVES + wave;
                if (r < 32 * 16) { wt_item(w_out, 1024, 32 * (r / 16), 64 * (r % 16), nullptr, WOUT, 1024, 32 * (r / 16), 64 * (r % 16), scr, lane); continue; } r -= 32 * 16;
                if (r < 88 * 16) { wt_item(w_gate, D_FF, 32 * (r / 16), 64 * (r % 16), ffn_norm_g, WG, 1024, 32 * (r / 16), 64 * (r % 16), scr, lane); continue; } r -= 88 * 16;
                if (r < 88 * 16) { wt_item(w_up, D_FF, 32 * (r / 16), 64 * (r % 16), ffn_norm_g, WU, 1024, 32 * (r / 16), 64 * (r % 16), scr, lane); continue; } r -= 88 * 16;
                if (r < 32 * 44) { wt_item(w_down, 1024, 32 * (r / 44), 64 * (r % 44), nullptr, WD, D_FF, 32 * (r / 44), 64 * (r % 44), scr, lane); continue; } r -= 32 * 44;
                wt_item(w_ple_gate, 1024, 32 * (r / 16), 64 * (r % 16), ple_norm_g, WPG, 1024, 32 * (r / 16), 64 * (r % 16), scr, lane); }
              __syncthreads();
              if (tid == 0) QW[0] = __hip_atomic_fetch_add(qhead, 1u, __ATOMIC_RELAXED, __HIP_MEMORY_SCOPE_AGENT) + (unsigned)G;
              __syncthreads();
            } else { const int j = item - N_DIFF, qb = 31 - (j >> 5), bh = j & 31, b = bh >> 3, h = bh & 7;
              if (!p2ok) {
                if (tid == 0) { unsigned sp_ = 0u; while (__hip_atomic_load((unsigned*)ctl + CW_P2DONE, __ATOMIC_RELAXED, __HIP_MEMORY_SCOPE_AGENT) < (unsigned)G && ++sp_ < (1u << 22)) __builtin_amdgcn_s_sleep(2);
                                __builtin_amdgcn_fence(__ATOMIC_ACQUIRE, "agent"); }
                __syncthreads(); p2ok = true; }
              attn::UnitP P{QR + 96 * h, 768, KM + kimg(12, b * 8 + h, 0, 0, 0), 0, VM + vimg(2, b * 8 + h, 0, 0, 0, 0, 0), 0, Y + 64 * h, 1024, qb, (long)b * SEQ, nullptr, BTAB + 4097, nullptr, nullptr, nullptr, nullptr,
                            qhead, (unsigned)G, QW};
              if (IW_MLA && att_fixed_mla) attn::attn_unit_iw<6, 2, true>(P, lds, ROPE, mla_q_norm_g); else attn::attn_unit<6, 2, true>(P, lds, ROPE, mla_q_norm_g); }
            item = __builtin_amdgcn_readfirstlane((int)QW[0]);
          } }
        asm volatile("s_waitcnt vmcnt(0)" ::: "memory"); __syncthreads();
        if (tid == 0) { __builtin_amdgcn_fence(__ATOMIC_RELEASE, "agent"); (void)__hip_atomic_fetch_add((unsigned*)ctl + CW_P3DONE, 1u, __ATOMIC_RELAXED, __HIP_MEMORY_SCOPE_AGENT); }
        { PHASE_PTRS();
          const int per = (512 + G - 1) / G, u0 = per * bx, u1 = (u0 + per < 512 ? u0 + per : 512);
          if (u0 < 512) { const int r0 = (u0 >> 2) * 256, r1 = ((u1 - 1) >> 2) * 256 + 256; convert_p_rows(p_in, PB, r0, r1 - r0, tid);
              pg8::Gemm g2{PB, WPP, T_TOK, 1024, 256, 256}; PanelOrder S2{0, bx, per, 512}; EpiBf E2{PRB}; pg8::gemm_phase(lds, g2, S2, E2); } }
        if (tid == 0) { unsigned sp_ = 0u; while (__hip_atomic_load((unsigned*)ctl + CW_P3DONE, __ATOMIC_RELAXED, __HIP_MEMORY_SCOPE_AGENT) < (unsigned)G && ++sp_ < (1u << 22)) __builtin_amdgcn_s_sleep(2);
                        __builtin_amdgcn_fence(__ATOMIC_ACQUIRE, "agent"); }
        __syncthreads();
    }
    if (IN(5)) for (int rep_ = 0; rep_ < NREP(5); ++rep_) {
        PHASE_PTRS();
        pg8::Gemm g{Y, WOUT, T_TOK, 1024, 1024, 1024}; pg8::StaticOrder S; S.init(T_TOK, 1024, G, bx);
        EpiRes<false> E{x, X1B, SS1};
        pg8::gemm_phase(lds, g, S, E);
        if (BOTH(5)) GRID_BAR();
    }
    if (IN(6)) {
        { PHASE_PTRS();
          bool six;
          { pg8::Gemm g{X1B, WG, T_TOK, D_FF, 1024, 1024}; pg8::StaticOrder S; S.init(T_TOK, D_FF, G, bx);
            pg8::Unit u5, u6; u5.pm = -1; u5.pn = -1; (void)S.next(4, u5); six = S.next(5, u6);
            EpiGateW E{EpiGate{GT, SS1}, (unsigned*)ctl + CW_GDONE, six ? u5.pm : -1, six ? u5.pn : -1};
            pg8::gemm_phase(lds, g, S, E); }
          if (tid == 0) { __builtin_amdgcn_fence(__ATOMIC_RELEASE, "agent");
              if (!six) (void)__hip_atomic_fetch_add((unsigned*)ctl + CW_GDONE, 1u, __ATOMIC_RELAXED, __HIP_MEMORY_SCOPE_AGENT);
              (void)__hip_atomic_fetch_add((unsigned*)ctl + CW_GDONE + 16, 1u, __ATOMIC_RELAXED, __HIP_MEMORY_SCOPE_AGENT); }
          { pg8::Gemm g{X1B, WU, T_TOK, D_FF, 1024, 1024}; pg8::StaticOrder S; S.init(T_TOK, D_FF, G, (bx + G / 2) % G);
            pg8::Unit ua, ub; ua.pm = -1; ua.pn = -1; ub.pm = -1; ub.pn = -1; (void)S.next(0, ua); (void)S.next(1, ub);
            EpiUpActW E{EpiUpAct{GT, ACT, SS1, conv_w, conv_b}, (unsigned*)ctl + CW_GDONE, G, ua.pm, ua.pn, ub.pm, ub.pn};
            pg8::gemm_phase(lds, g, S, E); }
        }
        if (BOTH(6) || IN(8)) GRID_BAR();
    }
    if (IN(8)) {
        PHASE_PTRS();
        pg8::Gemm g{ACT, WD, T_TOK, 1024, D_FF, D_FF}; pg8::StaticOrder S; S.init(T_TOK, 1024, G, bx);
        EpiRes<true> E{X1B, X2B, SS2};
        pg8::gemm_phase(lds, g, S, E);
        if (BOTH(8)) GRID_BAR();
    }
    if (IN(9)) {
        PHASE_PTRS();
        { pg8::Gemm g{X2B, WPG, T_TOK, 1024, 1024, 1024}; pg8::StaticOrder S; S.init(T_TOK, 1024, G, bx); EpiPle E{out, X2B, PRB, SS2}; pg8::gemm_phase(lds, g, S, E); }
    }
#undef IN
#undef BOTH
#undef GRID_BAR
}

extern "C" void kernel_launch(void* const* d_in, const int* in_sizes, int n_in, void* d_out, int out_size, void* d_ws, size_t ws_size, hipStream_t stream) {
    static int grid = 0;
    if (grid == 0) {
        if (n_in != 28 || out_size != T_TOK * D_MODEL || ws_size < WS_END) { fprintf(stderr, "kernel_launch: unexpected shapes (n_in %d out %d ws %zu)\n", n_in, out_size, ws_size); grid = -1; return; }
        int dev = 0, cus = 0, per_cu = 0;
        if (hipGetDevice(&dev) != hipSuccess || hipDeviceGetAttribute(&cus, hipDeviceAttributeMultiprocessorCount, dev) != hipSuccess) { grid = -1; return; }
        if (hipFuncSetAttribute((const void*)mk_fwd, hipFuncAttributeMaxDynamicSharedMemorySize, LDS_BYTES) != hipSuccess) { fprintf(stderr, "kernel_launch: hipFuncSetAttribute failed\n"); grid = -1; return; }
        if (hipOccupancyMaxActiveBlocksPerMultiprocessor(&per_cu, (const void*)mk_fwd, NWAVES * 64, LDS_BYTES) != hipSuccess || per_cu < 1) { fprintf(stderr, "kernel_launch: occupancy query says %d blocks per CU\n", per_cu); }
        (void)hipGetLastError();
        grid = cus;
    }
    if (grid < 0) return;
    (void)hipMemsetAsync((char*)d_ws + WS_CTL, 0, CTL_ZERO_BYTES, stream);
    Args a{};
    for (int i = 0; i < 28; ++i) a.in[i] = (const float*)d_in[i];
    a.out = (float*)d_out; a.ws = (unsigned char*)d_ws;
#if MK_N_LAUNCHES == 1
    a.ph_lo = 0; a.ph_hi = N_PHASES;
    void* kargs[] = {&a};
    hipError_t e = hipLaunchCooperativeKernel((const void*)mk_fwd, dim3(grid), dim3(NWAVES * 64), kargs, LDS_BYTES, stream);
    if (e != hipSuccess) fprintf(stderr, "kernel_launch: cooperative launch failed: %s (grid %d)\n", hipGetErrorString(e), grid);
#else
    for (int ph = 0; ph < N_PHASES; ++ph) { a.ph_lo = ph; a.ph_hi = ph + 1; hipLaunchKernelGGL(mk_fwd, dim3(grid), dim3(NWAVES * 64), LDS_BYTES, stream, a); }
#endif
}
```
